# Optimizing an MI355X kernel written in HIP

```python
import math, functools
import jax, jax.numpy as jnp
from jax import lax
import numpy as np

D_MODEL = 1024
BATCH = 4
SEQ = 8192
DEPTH = 4

HEAD_DIM = 64
N_HEADS = 8
N_KV_GROUPS = 2
Q_W = N_HEADS * HEAD_DIM
KV_W = N_KV_GROUPS * HEAD_DIM
NSA_GATE_W = N_HEADS * 3
L_CMP = 32
CMP_STRIDE = 16
L_SEL = 64
N_TOPK = 16
W_WIN = 512
Q_BLK = 64
PHI_HIDDEN = 256
SGU_GROUPS = 8
SGU_HEAD = 64
SGU_W = SGU_GROUPS * SGU_HEAD
CHUNK = 128
D_FF = 2816
ROPE_THETA = 10000.0
EPS = 1e-6
NEG_INF = -1e30
FORCE = 1e9

IN_WIDTHS = (Q_W, KV_W, KV_W, KV_W, KV_W, KV_W, KV_W, NSA_GATE_W, 2 * SGU_W, D_MODEL, D_MODEL)
IN_SPLITS = tuple(int(s) for s in np.cumsum(IN_WIDTHS)[:-1])
IN_TOTAL = int(sum(IN_WIDTHS))

kernel_name = "hybrid_nsa_gmlp_macaron_trunk"


def rmsnorm(x, g):
    xf = x.astype(jnp.float32)
    y = xf * lax.rsqrt(jnp.mean(xf * xf, axis=-1, keepdims=True) + EPS)
    return (y * g.astype(jnp.float32)).astype(x.dtype)


def swiglu(h, w_gate_up, w_down):
    g, u = jnp.split(h @ w_gate_up, 2, axis=-1)
    return (jax.nn.silu(g) * u) @ w_down


def rope(x, pos):
    dh = x.shape[-1]
    inv = ROPE_THETA ** (-jnp.arange(0, dh, 2, dtype=jnp.float32) / dh)
    ang = pos.astype(jnp.float32)[:, None] * inv[None, :]
    cos = jnp.concatenate([jnp.cos(ang)] * 2, axis=-1)[:, None, :].astype(x.dtype)
    sin = jnp.concatenate([jnp.sin(ang)] * 2, axis=-1)[:, None, :].astype(x.dtype)
    x1, x2 = jnp.split(x, 2, axis=-1)
    return x * cos + jnp.concatenate([-x2, x1], axis=-1) * sin


def masked_softmax(s, mask):
    s = jnp.where(mask, s.astype(jnp.float32), NEG_INF)
    return jax.nn.softmax(s, axis=-1)


def nsa_attention(q, k_cmp, v_cmp, k_sel, v_sel, k_win, v_win, gates,
                  pos_k, pos_v, phik1, phik2, phiv1, phiv2):
    B, S, H, Dh = q.shape
    G = N_KV_GROUPS
    HPG = H // G
    scale = Dh ** -0.5
    n_cmp = (S - L_CMP) // CMP_STRIDE + 1
    n_sel = S // L_SEL
    n_topk = min(N_TOPK, n_sel)

    tok_idx = jnp.arange(n_cmp)[:, None] * CMP_STRIDE + jnp.arange(L_CMP)[None, :]

    def compress(kv, pe, w1, w2):
        blk = kv[:, tok_idx] + pe[None, None, :, None, :]
        flat = blk.transpose(0, 1, 3, 2, 4).reshape(B, n_cmp, G, L_CMP * Dh)
        return jax.nn.gelu(flat @ w1) @ w2

    cmp_start = jnp.arange(n_cmp) * CMP_STRIDE
    cmp_end = cmp_start + (L_CMP - 1)
    kc = rope(compress(k_cmp, pos_k, phik1, phik2), cmp_end)
    vc = compress(v_cmp, pos_v, phiv1, phiv2)

    sel_start = jnp.arange(n_sel) * L_SEL
    ov = jnp.minimum(cmp_start[:, None] + L_CMP, sel_start[None, :] + L_SEL) - \
        jnp.maximum(cmp_start[:, None], sel_start[None, :])
    sel_map = (jnp.clip(ov, 0) / L_CMP).astype(jnp.float32)

    ksb = k_sel.reshape(B, n_sel, L_SEL, G, Dh).transpose(0, 3, 1, 2, 4)
    vsb = v_sel.reshape(B, n_sel, L_SEL, G, Dh).transpose(0, 3, 1, 2, 4)
    kwp = jnp.pad(k_win, ((0, 0), (W_WIN, 0), (0, 0), (0, 0)))
    vwp = jnp.pad(v_win, ((0, 0), (W_WIN, 0), (0, 0), (0, 0)))
    bi = jnp.arange(B)[:, None, None, None]
    gi = jnp.arange(G)[None, :, None, None]
    blk_ids = jnp.arange(n_sel)

    def q_block(qb):
        q0 = qb * Q_BLK
        t = q0 + jnp.arange(Q_BLK)
        qh = lax.dynamic_slice_in_dim(q, q0, Q_BLK, axis=1).reshape(B, Q_BLK, G, HPG, Dh)
        gb = lax.dynamic_slice_in_dim(gates, q0, Q_BLK, axis=1).reshape(B, Q_BLK, G, HPG, 3)

        s = jnp.einsum('bqghd,bngd->bghqn', qh, kc) * scale
        valid = cmp_end[None, :] <= t[:, None]
        p_cmp = masked_softmax(s, valid) * jnp.any(valid, axis=-1)[:, None]
        o_cmp = jnp.einsum('bghqn,bngd->bqghd', p_cmp.astype(vc.dtype), vc)

        imp = jnp.einsum('bghqn,nj->bgqj', p_cmp, sel_map)
        cur = t // L_SEL
        imp = jnp.where(blk_ids[None, :] == cur[:, None], FORCE,
                        jnp.where(blk_ids[None, :] > cur[:, None], -FORCE, imp))
        _, idx = lax.top_k(imp, n_topk)
        ks = ksb[bi, gi, idx]
        vs = vsb[bi, gi, idx]
        kpos = idx[..., None] * L_SEL + jnp.arange(L_SEL)
        smask = (kpos <= t[:, None, None]).reshape(B, G, 1, Q_BLK, n_topk * L_SEL)
        s = jnp.einsum('bqghd,bgqkld->bghqkl', qh, ks) * scale
        p = masked_softmax(s.reshape(B, G, HPG, Q_BLK, n_topk * L_SEL), smask)
        o_sel = jnp.einsum('bghqx,bgqxd->bqghd', p.astype(vs.dtype),
                           vs.reshape(B, G, Q_BLK, n_topk * L_SEL, Dh))

        kw = lax.dynamic_slice_in_dim(kwp, q0, W_WIN + Q_BLK, axis=1)
        vw = lax.dynamic_slice_in_dim(vwp, q0, W_WIN + Q_BLK, axis=1)
        wpos = q0 - W_WIN + jnp.arange(W_WIN + Q_BLK)
        d = t[:, None] - wpos[None, :]
        wmask = (d >= 0) & (d < W_WIN) & (wpos[None, :] >= 0)
        s = jnp.einsum('bqghd,bkgd->bghqk', qh, kw) * scale
        p = masked_softmax(s, wmask)
        o_win = jnp.einsum('bghqk,bkgd->bqghd', p.astype(vw.dtype), vw)

        o = gb[..., 0:1] * o_cmp + gb[..., 1:2] * o_sel + gb[..., 2:3] * o_win
        return o.reshape(B, Q_BLK, H * Dh)

    out = lax.map(q_block, jnp.arange(S // Q_BLK))
    return out.transpose(1, 0, 2, 3).reshape(B, S, H * Dh)


def spatial_gating(uv, norm_g, w_s, b_s):
    u, v = jnp.split(jax.nn.gelu(uv), 2, axis=-1)
    v = rmsnorm(v, norm_g)
    B, S, _ = v.shape
    v = v.reshape(B, S // CHUNK, CHUNK, SGU_GROUPS, SGU_HEAD)
    ws = w_s * jnp.tril(jnp.ones((CHUNK, CHUNK), w_s.dtype))
    v = jnp.einsum('gts,bcsgd->bctgd', ws, v) + b_s.T[None, None, :, :, None]
    return u * v.reshape(B, S, SGU_W)


def setup_inputs(seed: int = 0) -> dict:
    key = jax.random.key(seed)
    ks = jax.random.split(key, 24)
    f32 = jnp.float32

    def nrm(k, shape, scale):
        return jax.random.normal(k, shape, f32) * scale

    def gain(k, shape):
        return 1.0 + 0.01 * jax.random.normal(k, shape, f32)

    L = DEPTH
    return {
        "x": jax.random.normal(ks[0], (BATCH, SEQ, D_MODEL), f32),
        "ffn1_norm": gain(ks[1], (L, D_MODEL)),
        "ffn1_w_gate_up": nrm(ks[2], (L, D_MODEL, 2 * D_FF), D_MODEL ** -0.5),
        "ffn1_w_down": nrm(ks[3], (L, D_FF, D_MODEL), D_FF ** -0.5),
        "mix_norm": gain(ks[4], (L, D_MODEL)),
        "w_in": nrm(ks[5], (L, D_MODEL, IN_TOTAL), D_MODEL ** -0.5),
        "cmp_pos_k": nrm(ks[6], (L, L_CMP, HEAD_DIM), 0.1),
        "cmp_pos_v": nrm(ks[7], (L, L_CMP, HEAD_DIM), 0.1),
        "phi_k_w1": nrm(ks[8], (L, L_CMP * HEAD_DIM, PHI_HIDDEN), (L_CMP * HEAD_DIM) ** -0.5),
        "phi_k_w2": nrm(ks[9], (L, PHI_HIDDEN, HEAD_DIM), PHI_HIDDEN ** -0.5),
        "phi_v_w1": nrm(ks[10], (L, L_CMP * HEAD_DIM, PHI_HIDDEN), (L_CMP * HEAD_DIM) ** -0.5),
        "phi_v_w2": nrm(ks[11], (L, PHI_HIDDEN, HEAD_DIM), PHI_HIDDEN ** -0.5),
        "sgu_norm": gain(ks[12], (L, SGU_W)),
        "sgu_w_s": nrm(ks[13], (L, SGU_GROUPS, CHUNK, CHUNK), CHUNK ** -0.5),
        "sgu_b_s": gain(ks[14], (L, SGU_GROUPS, CHUNK)),
        "proj_a": nrm(ks[15], (L, Q_W, D_MODEL), Q_W ** -0.5),
        "proj_b": nrm(ks[16], (L, SGU_W, D_MODEL), SGU_W ** -0.5),
        "w_out": nrm(ks[17], (L, D_MODEL, D_MODEL), D_MODEL ** -0.5),
        "ffn2_norm": gain(ks[18], (L, D_MODEL)),
        "ffn2_w_gate_up": nrm(ks[19], (L, D_MODEL, 2 * D_FF), D_MODEL ** -0.5),
        "ffn2_w_down": nrm(ks[20], (L, D_FF, D_MODEL), D_FF ** -0.5),
        "final_norm": gain(ks[21], (D_MODEL,)),
    }


def reference(x, ffn1_norm, ffn1_w_gate_up, ffn1_w_down, mix_norm, w_in,
              cmp_pos_k, cmp_pos_v, phi_k_w1, phi_k_w2, phi_v_w1, phi_v_w2,
              sgu_norm, sgu_w_s, sgu_b_s, proj_a, proj_b, w_out,
              ffn2_norm, ffn2_w_gate_up, ffn2_w_down, final_norm):
    B, S, _ = x.shape
    pos = jnp.arange(S)
    for l in range(DEPTH):
        x = x + 0.5 * swiglu(rmsnorm(x, ffn1_norm[l]), ffn1_w_gate_up[l], ffn1_w_down[l])

        h = rmsnorm(x, mix_norm[l])
        (q, kc, vc, ksel, vsel, kwin, vwin, g_nsa, uv, g_a, g_b) = \
            jnp.split(h @ w_in[l], IN_SPLITS, axis=-1)
        q = rope(q.reshape(B, S, N_HEADS, HEAD_DIM), pos)
        kv = lambda t: t.reshape(B, S, N_KV_GROUPS, HEAD_DIM)
        y_a = nsa_attention(
            q, kv(kc), kv(vc), rope(kv(ksel), pos), kv(vsel), rope(kv(kwin), pos), kv(vwin),
            jax.nn.sigmoid(g_nsa).reshape(B, S, N_HEADS, 3),
            cmp_pos_k[l], cmp_pos_v[l], phi_k_w1[l], phi_k_w2[l], phi_v_w1[l], phi_v_w2[l])
        y_b = spatial_gating(uv, sgu_norm[l], sgu_w_s[l], sgu_b_s[l])
        merged = jax.nn.sigmoid(g_a) * (y_a @ proj_a[l]) + jax.nn.sigmoid(g_b) * (y_b @ proj_b[l])
        x = x + merged @ w_out[l]

        x = x + 0.5 * swiglu(rmsnorm(x, ffn2_norm[l]), ffn2_w_gate_up[l], ffn2_w_down[l])
    return rmsnorm(x, final_norm)
```

```cpp
#include <hip/hip_runtime.h>
#include <hip/hip_cooperative_groups.h>
#include <cstdio>
#include <cstdint>
namespace cg = cooperative_groups;
namespace pg8 {
#define PG8_LAS __attribute__((address_space(3)))
typedef unsigned short bf16_t;
typedef short bf16x8 __attribute__((ext_vector_type(8)));
typedef float f32x4 __attribute__((ext_vector_type(4)));
typedef unsigned u32x4 __attribute__((ext_vector_type(4)));
constexpr int BM = 256, BK = 64, HALF = 128, HTB = HALF * BK * 2  , STAGE_BYTES = 8 * HTB, NXCD = 8, WGM = 8;

__host__ __device__ __forceinline__ int lds_byte(int r, int c) { const int st = (r >> 4) * 2 + (c >> 5), rr = r & 15, cc = c & 31, ob = rr * 64 + cc * 2; return st * 1024 + (ob ^ (((ob >> 9) & 1) << 5)); }
__host__ __device__ __forceinline__ void stage_rc(int b, int& R, int& C) { const int st = b / 1024, sb = b % 1024, swz = sb ^ (((sb >> 9) & 1) << 5); R = (st >> 1) * 16 + swz / 64; C = (st & 1) * 32 + (swz % 64) / 2; }
__host__ __device__ __forceinline__ int perm32(int rho) { const int n = rho >> 4, i = rho & 15; return 8 * (i >> 2) + 4 * n + (i & 3); }

struct Unit { int pm, pn; };
struct Gemm { const bf16_t* A; const bf16_t* Bt; int M, N, K; };

struct StaticOrder {
    int nM, nN, nwg, G, c;
    __host__ __device__ void init(int M, int N, int G_, int c_) { nM = M / BM; nN = N / BM; nwg = nM * nN; G = G_; c = c_; }
    __host__ __device__ bool next(int i, Unit& u) const {
        const long L = (long)i * G + c; if (L >= nwg) return false;
        int wgid = (int)L; { const int q = nwg / NXCD, r = nwg % NXCD, xcd = wgid % NXCD, off = wgid / NXCD; wgid = (xcd < r ? xcd * (q + 1) : r * (q + 1) + (xcd - r) * q) + off; }
        const int nig = WGM * nN, gid = wgid / nig, fm = gid * WGM, gsz = (nM - fm) < WGM ? (nM - fm) : WGM;
        u.pm = fm + ((wgid % nig) % gsz); u.pn = (wgid % nig) / gsz; return true;
    }
    __device__ __forceinline__ void a_ready(const Unit&) const {}
    __device__ __forceinline__ void done(const Unit&) const {}
};
__device__ __forceinline__ unsigned cvt_pk_bf16(float lo, float hi) { unsigned r; asm volatile("v_cvt_pk_bf16_f32 %0, %1, %2" : "=v"(r) : "v"(lo), "v"(hi)); return r; }
typedef float f32x2 __attribute__((ext_vector_type(2)));
template <class Epi, class Sched, bool ALIGN_EPI = false, bool SP2 = false>
__device__ __forceinline__ void gemm_phase(PG8_LAS unsigned char* lds, const Gemm g, const Sched& S, const Epi& E) {
    int tid0_ = threadIdx.x; asm volatile("" : "+v"(tid0_));
    const int tid = tid0_, wid = __builtin_amdgcn_readfirstlane(tid >> 6), lane = tid & 63, wr = wid >> 2, wc = wid & 3, fr = lane & 15, fq = lane >> 4;
    const int K = g.K, nt = K / BK;
    unsigned voffA[2], voffB[2];
#pragma unroll
    for (int i = 0; i < 2; ++i) { int R, C; stage_rc(tid * 16 + i * 8192, R, C); const int Rb = Epi::PERM ? ((R & ~31) + perm32(R & 31)) : R;
        voffA[i] = (unsigned)(R * K + C) * 2u; voffB[i] = (unsigned)(Rb * K + C) * 2u; }
    const size_t kstep = (size_t)(BK * 2);
    const size_t hstep = (size_t)HALF * K * 2;
    const size_t tstep = 2 * hstep;
    const unsigned ldsw = (unsigned)wid * 1024u;
    const int aoff = lds_byte(wr * 64 + fr, fq * 8), boff = lds_byte(wc * 32 + fr, fq * 8);
#define PG8_SA(b, h) (((b) * 2 + (h)) * HTB)
#define PG8_SB(b, h) ((4 + (b) * 2 + (h)) * HTB)
#define PG8_STAGE(bufoff, gbase, voff) do { _Pragma("unroll") for (int _i = 0; _i < 2; ++_i) \
        __builtin_amdgcn_global_load_lds((const unsigned*)((const char*)(gbase) + (voff)[_i]), (PG8_LAS unsigned*)(lds + (bufoff) + ldsw + _i * 8192), 16, 0, 0); } while (0)
#define PG8_LDA(dst, b, h) do { _Pragma("unroll") for (int m = 0; m < 4; ++m) _Pragma("unroll") for (int k = 0; k < 2; ++k) dst[m][k] = *(const PG8_LAS bf16x8*)(lds + PG8_SA(b, h) + aoff + m * 2048 + k * 1024); } while (0)
#define PG8_LDB(dst, b, h) do { _Pragma("unroll") for (int n = 0; n < 2; ++n) _Pragma("unroll") for (int k = 0; k < 2; ++k) dst[n][k] = *(const PG8_LAS bf16x8*)(lds + PG8_SB(b, h) + boff + n * 2048 + k * 1024); } while (0)
#define PG8_MMA(ai, bj, At, Bt) do { __builtin_amdgcn_s_setprio(1); _Pragma("unroll") for (int m = 0; m < 4; ++m) _Pragma("unroll") for (int n = 0; n < 2; ++n) _Pragma("unroll") for (int k = 0; k < 2; ++k) \
        acc[ai][bj][m][n] = __builtin_amdgcn_mfma_f32_16x16x32_bf16(Bt[n][k], At[m][k], acc[ai][bj][m][n], 0, 0, 0); __builtin_amdgcn_s_setprio(0); } while (0)
#define PG8_WAIT_V(n) asm volatile("s_waitcnt vmcnt(" #n ")" ::: "memory")
#define PG8_WAIT_L(n) asm volatile("s_waitcnt lgkmcnt(" #n ")" ::: "memory")
#define PG8_BAR __builtin_amdgcn_s_barrier()
#define PG8_SCHED __builtin_amdgcn_sched_barrier(0)
    Unit cur, nxt; int ui = 0;
    if (!S.next(0, cur)) return;
    f32x4 acc[2][2][4][2];
#pragma unroll
    for (int a = 0; a < 2; ++a)
#pragma unroll
        for (int b = 0; b < 2; ++b)
#pragma unroll
            for (int m = 0; m < 4; ++m)
#pragma unroll
                for (int n = 0; n < 2; ++n) acc[a][b][m][n] = (f32x4){0.f, 0.f, 0.f, 0.f};
    bf16x8 At[4][2], B0[2][2], B1[2][2];
    const char* cA = (const char*)g.A + (size_t)cur.pm * tstep; const char* cB = (const char*)g.Bt + (size_t)cur.pn * tstep;
    S.a_ready(cur);
    if constexpr (SP2) {
        PG8_STAGE(PG8_SB(0, 0), cB, voffB); PG8_STAGE(PG8_SB(0, 1), cB + hstep, voffB); PG8_STAGE(PG8_SA(0, 0), cA, voffA); PG8_STAGE(PG8_SA(0, 1), cA + hstep, voffA);
        if (wr == 1) PG8_BAR;
        PG8_WAIT_V(2); PG8_BAR;
        PG8_STAGE(PG8_SB(1, 0), cB + kstep, voffB); PG8_STAGE(PG8_SA(1, 0), cA + kstep, voffA); PG8_STAGE(PG8_SB(1, 1), cB + hstep + kstep, voffB);
        PG8_WAIT_V(6); PG8_BAR;
    } else {
        PG8_STAGE(PG8_SB(0, 0), cB, voffB); PG8_STAGE(PG8_SA(0, 0), cA, voffA); PG8_STAGE(PG8_SB(0, 1), cB + hstep, voffB); PG8_STAGE(PG8_SA(0, 1), cA + hstep, voffA);
        if (wr == 1) PG8_BAR;
        PG8_WAIT_V(4); PG8_BAR;
        PG8_STAGE(PG8_SB(1, 0), cB + kstep, voffB); PG8_STAGE(PG8_SA(1, 0), cA + kstep, voffA); PG8_STAGE(PG8_SB(1, 1), cB + hstep + kstep, voffB);
        PG8_WAIT_V(6); PG8_BAR;
    }
    for (;;) {
        const bool has_next = S.next(ui + 1, nxt);
        const char* nA = has_next ? (const char*)g.A + (size_t)nxt.pm * tstep : cA; const char* nB = has_next ? (const char*)g.Bt + (size_t)nxt.pn * tstep : cB;
        for (int t = 0; t < nt; t += 2) {
            const bool last = (t == nt - 2);
            const char* a1 = cA + (size_t)(t + 1) * kstep;
            const char* a2 = last ? nA : cA + (size_t)(t + 2) * kstep; const char* b2 = last ? nB : cB + (size_t)(t + 2) * kstep;
            const char* a3 = a2 + kstep; const char* b3 = b2 + kstep;
            if (last && has_next) S.a_ready(nxt);
            if constexpr (SP2) {
            PG8_LDB(B0, 0, 0); PG8_LDB(B1, 0, 1); PG8_SCHED; PG8_LDA(At, 0, 0); PG8_STAGE(PG8_SA(1, 1), a1 + hstep, voffA);
            PG8_WAIT_V(8); PG8_WAIT_L(0); PG8_BAR; PG8_MMA(0, 0, At, B0); PG8_MMA(0, 1, At, B1); PG8_BAR; PG8_SCHED;
            PG8_LDA(At, 0, 1); PG8_STAGE(PG8_SB(0, 0), b2, voffB); PG8_STAGE(PG8_SB(0, 1), b2 + hstep, voffB); PG8_STAGE(PG8_SA(0, 0), a2, voffA);
            PG8_WAIT_V(8); PG8_WAIT_L(0); PG8_BAR; PG8_MMA(1, 0, At, B0); PG8_MMA(1, 1, At, B1); PG8_BAR; PG8_SCHED;
            PG8_LDB(B0, 1, 0); PG8_LDB(B1, 1, 1); PG8_SCHED; PG8_LDA(At, 1, 0); PG8_STAGE(PG8_SA(0, 1), a2 + hstep, voffA);
            PG8_WAIT_V(8); PG8_WAIT_L(0); PG8_BAR; PG8_MMA(0, 0, At, B0); PG8_MMA(0, 1, At, B1); PG8_BAR; PG8_SCHED;
            PG8_LDA(At, 1, 1); PG8_STAGE(PG8_SB(1, 0), b3, voffB); PG8_STAGE(PG8_SB(1, 1), b3 + hstep, voffB); PG8_STAGE(PG8_SA(1, 0), a3, voffA);
            PG8_WAIT_V(8); PG8_WAIT_L(0); PG8_BAR; PG8_MMA(1, 0, At, B0); PG8_MMA(1, 1, At, B1); PG8_BAR; PG8_SCHED;
            } else {
            PG8_LDB(B0, 0, 0); PG8_SCHED; PG8_LDA(At, 0, 0); PG8_STAGE(PG8_SA(1, 1), a1 + hstep, voffA);
            PG8_WAIT_L(8); PG8_BAR; PG8_WAIT_L(0); PG8_MMA(0, 0, At, B0); PG8_BAR; PG8_SCHED;
            PG8_LDB(B1, 0, 1); PG8_STAGE(PG8_SB(0, 0), b2, voffB);
            PG8_BAR; PG8_WAIT_L(0); PG8_MMA(0, 1, At, B1); PG8_BAR;
            PG8_LDA(At, 0, 1); PG8_STAGE(PG8_SA(0, 0), a2, voffA);
            PG8_BAR; PG8_WAIT_L(0); PG8_MMA(1, 0, At, B0); PG8_BAR; PG8_SCHED;
            PG8_STAGE(PG8_SB(0, 1), b2 + hstep, voffB);
            PG8_WAIT_V(6); PG8_BAR; PG8_MMA(1, 1, At, B1); PG8_BAR;
            PG8_LDB(B0, 1, 0); PG8_SCHED; PG8_LDA(At, 1, 0); PG8_STAGE(PG8_SA(0, 1), a2 + hstep, voffA);
            PG8_WAIT_L(8); PG8_BAR; PG8_WAIT_L(0); PG8_MMA(0, 0, At, B0); PG8_BAR; PG8_SCHED;
            PG8_LDB(B1, 1, 1); PG8_STAGE(PG8_SB(1, 0), b3, voffB);
            PG8_BAR; PG8_WAIT_L(0); PG8_MMA(0, 1, At, B1); PG8_BAR;
            PG8_LDA(At, 1, 1); PG8_STAGE(PG8_SA(1, 0), a3, voffA);
            PG8_BAR; PG8_WAIT_L(0); PG8_MMA(1, 0, At, B0); PG8_BAR; PG8_SCHED;
            PG8_STAGE(PG8_SB(1, 1), b3 + hstep, voffB);
            PG8_WAIT_V(6); PG8_BAR; PG8_MMA(1, 1, At, B1); PG8_BAR;
            }
        }
        if constexpr (ALIGN_EPI) { if (wr == 0) PG8_BAR; }
        if constexpr (!Epi::AFTER_DRAIN) { E(acc, cur, wr, wc, fr, fq); S.done(cur); }
        if (!has_next) break;
#pragma unroll
        for (int a = 0; a < 2; ++a)
#pragma unroll
            for (int b = 0; b < 2; ++b)
#pragma unroll
                for (int m = 0; m < 4; ++m)
#pragma unroll
                    for (int n = 0; n < 2; ++n) acc[a][b][m][n] = (f32x4){0.f, 0.f, 0.f, 0.f};
        cur = nxt; cA = nA; cB = nB; ++ui;
        if constexpr (ALIGN_EPI) { if (wr == 1) PG8_BAR; }
    }
    PG8_WAIT_V(0);
    if constexpr (!ALIGN_EPI) { if (wr == 0) PG8_BAR; }
    PG8_BAR;
    if constexpr (Epi::AFTER_DRAIN) { E.fused(acc, cur, wr, wc, fr, fq, lds, wid, lane); S.done(cur); }
#undef PG8_SA
#undef PG8_SB
#undef PG8_STAGE
#undef PG8_LDA
#undef PG8_LDB
#undef PG8_MMA
#undef PG8_WAIT_V
#undef PG8_WAIT_L
#undef PG8_BAR
#undef PG8_SCHED
}
}

#define DI __device__ __forceinline__
#define LAS __attribute__((address_space(3)))
typedef LAS unsigned char lds_u8;
typedef pg8::bf16_t bf16_t;
typedef pg8::bf16x8 bf16x8;
typedef pg8::f32x4 f32x4;
typedef pg8::u32x4 u32x4;
typedef float f32x16 __attribute__((ext_vector_type(16)));
typedef unsigned u32x2 __attribute__((ext_vector_type(2)));
typedef unsigned long long u64;

constexpr int NB = 4, SEQ = 8192, DM = 1024, MT = NB * SEQ, DFF = 2816, NGU = 5632, NINP = 4608, NINS = 4376, DEPTH = 4;
constexpr float EPS = 1e-6f;
constexpr float C2 = 0.125f * 1.4426950408889634f;
constexpr int LDS_BYTES = 143360, XB_ST_OFF = 143360 - 64;

constexpr size_t MiB = 1u << 20;
constexpr size_t W_GU1 = 0, W_D1 = 11 * MiB, W_IN = W_D1 + 11 * MiB / 2, W_1K = W_IN + 9 * MiB, W_1V = W_1K + 1 * MiB,
                 W_GU2 = W_1V + 1 * MiB, W_D2 = W_GU2 + 11 * MiB, W_PA = W_D2 + 11 * MiB / 2, W_PB = W_PA + 1 * MiB, W_WO = W_PB + 1 * MiB;
static_assert(W_WO + 2 * MiB == 48 * MiB, "weight map");
constexpr size_t WS_XG = 48 * MiB, WS_H = 112 * MiB;
constexpr size_t WS_Q = WS_H, WS_KSEL = WS_H + 32 * MiB, WS_KWIN = WS_H + 40 * MiB, WS_KC = WS_H + 48 * MiB, WS_VC = WS_H + 56 * MiB, WS_VSELT = WS_H + 64 * MiB,
                 WS_VWINT = WS_H + 72 * MiB, WS_U = WS_H + 80 * MiB, WS_VPT = WS_H + 112 * MiB, WS_YA = WS_H + 144 * MiB;
constexpr size_t WS_SGA = 288 * MiB, WS_SGB = 352 * MiB, WS_YB = 416 * MiB, WS_SSQ = 448 * MiB, WS_SSQV = 450 * MiB, WS_GN = 451 * MiB, WS_YK = 455 * MiB,
                 WS_YV = 463 * MiB, WS_KCMP = 471 * MiB, WS_VCMPT = 471 * MiB + 512 * 1024, WS_CS = 472 * MiB, WS_SN = 473 * MiB, WS_BIAS = 474 * MiB, W_ALT = 475 * MiB, WS_CTL = 503 * MiB, WS_END = 504 * MiB;

typedef float f32x2_t __attribute__((ext_vector_type(2)));
typedef __bf16 bf16x2_t __attribute__((ext_vector_type(2)));
DI unsigned pk2(float lo, float hi) { f32x2_t v = {lo, hi}; bf16x2_t b = __builtin_convertvector(v, bf16x2_t); return __builtin_bit_cast(unsigned, b); }
DI bf16_t f2bf(float v) { return (bf16_t)(pk2(v, 0.f) & 0xffffu); }
DI float bflo(unsigned w) { return __uint_as_float(w << 16); }
DI float bfhi(unsigned w) { return __uint_as_float(w & 0xffff0000u); }
DI float fexp(float x) { return __builtin_amdgcn_exp2f(x * 1.4426950408889634f); }
DI float sigmoidf_(float x) { return __builtin_amdgcn_rcpf(1.0f + fexp(-x)); }
DI float siluf_(float x) { return x * sigmoidf_(x); }
DI float gelu_tanh(float x) { const float u = 0.7978845608028654f * (x + 0.044715f * x * x * x); return x * sigmoidf_(2.0f * u); }
DI float wave_sum(float v) {
#pragma unroll
    for (int o = 1; o < 64; o <<= 1) v += __shfl_xor(v, o);
    return v;
}
#define XB_TMO      128
#define XB_XCNT(j)  (256  + 64 * (j))
#define XB_XSUB(j)  (1280 + 64 * (j))
#define XB_XGEN(j)  (2304 + 64 * (j))
#define XB_TOP      3328
#define XB_TOPGEN   3392
#define XCD_BAR_WORDS 3456
#define XB_SPIN_CAP (1u << 18)

__device__ __forceinline__ unsigned xb_ld(unsigned* p)              { return __hip_atomic_load(p, __ATOMIC_RELAXED, __HIP_MEMORY_SCOPE_AGENT); }
__device__ __forceinline__ unsigned xb_add(unsigned* p, unsigned v) { return __hip_atomic_fetch_add(p, v, __ATOMIC_RELAXED, __HIP_MEMORY_SCOPE_AGENT); }
__device__ __forceinline__ unsigned xb_xcc_id() { return (unsigned)__builtin_amdgcn_s_getreg((3 << 11) | 20) & 0xFu; }
#define XB_SPIN(cond, bar) do { unsigned _sp = 0; while (cond) { __builtin_amdgcn_s_sleep(1); \
    if ((++_sp & 255u) == 0u) { if (xb_ld(&(bar)[XB_TMO])) break; if (_sp > XB_SPIN_CAP) { atomicAdd(&(bar)[XB_TMO], 1u); break; } } } } while (0)

struct XcdBarrier {
    unsigned* bar; unsigned x;
    volatile LAS unsigned* st;
};

__device__ __forceinline__ XcdBarrier xcd_barrier_post(unsigned* bar, volatile LAS unsigned* st) {
    XcdBarrier b; b.bar = bar; b.x = xb_xcc_id(); b.st = st;
    if (threadIdx.x == 0) (void)xb_add(&bar[XB_XCNT(b.x)], 1u);
    return b;
}
__device__ __forceinline__ void xcd_barrier_complete(unsigned* bar, unsigned x, unsigned& nloc, unsigned& nx) {
    const unsigned G = gridDim.x * gridDim.y * gridDim.z;
    unsigned sum, cnt, mine, sp = 0u;
    for (;;) {
        sum = 0u; cnt = 0u; mine = 0u;
#pragma unroll
        for (unsigned j = 0; j < 16; ++j) { const unsigned c = xb_ld(&bar[XB_XCNT(j)]); sum += c; cnt += (c > 0u) ? 1u : 0u; mine = (j == x) ? c : mine; }
        if (sum == G) break;
        __builtin_amdgcn_s_sleep(1);
        if ((++sp & 255u) == 0u) { if (xb_ld(&bar[XB_TMO])) break; if (sp > XB_SPIN_CAP) { atomicAdd(&bar[XB_TMO], 1u); break; } }
    }
    nloc = mine > 0u ? mine : 1u; nx = cnt > 0u ? cnt : 1u;
}

__device__ __forceinline__ void xcd_barrier(const XcdBarrier& b) {
    asm volatile("s_waitcnt vmcnt(0)" ::: "memory");
    __syncthreads();
    if (threadIdx.x == 0) {
        unsigned* bar = b.bar;
        __builtin_amdgcn_s_waitcnt(0);
        unsigned nloc = b.st[0], nx = b.st[1];
        if (nloc == 0u) { xcd_barrier_complete(bar, b.x, nloc, nx); b.st[0] = nloc; b.st[1] = nx; }
        const unsigned old = xb_add(&bar[XB_XSUB(b.x)], 1u);
        const unsigned gen = old / nloc;
        if (old + 1u == (gen + 1u) * nloc) {
            __builtin_amdgcn_fence(__ATOMIC_RELEASE, "agent");
            asm volatile("s_waitcnt vmcnt(0)" ::: "memory");
            const unsigned og = xb_add(&bar[XB_TOP], 1u);
            const unsigned tg = og / nx;
            if (og + 1u == (tg + 1u) * nx) xb_add(&bar[XB_TOPGEN], 1u);
            else XB_SPIN(xb_ld(&bar[XB_TOPGEN]) == tg, bar);
            __builtin_amdgcn_fence(__ATOMIC_ACQUIRE, "agent");
            xb_add(&bar[XB_XGEN(b.x)], 1u);
            asm volatile("s_waitcnt vmcnt(0)" ::: "memory");
        } else {
            XB_SPIN(xb_ld(&bar[XB_XGEN(b.x)]) == gen, bar);
            __builtin_amdgcn_fence(__ATOMIC_ACQUIRE, "agent");
            asm volatile("s_waitcnt vmcnt(0)" ::: "memory");
        }
    }
    __syncthreads();
}

DI u32x4 pack8(const f32x4 a, const f32x4 b) { u32x4 w; w.x = pk2(a.x, a.y); w.y = pk2(a.z, a.w); w.z = pk2(b.x, b.y); w.w = pk2(b.z, b.w); return w; }

__host__ __device__ __forceinline__ int map_gateup(int n) { const int part = n / DFF, c = n % DFF; return 256 * (c >> 7) + 128 * part + (c & 127); }
__host__ __device__ __forceinline__ int map_rope(int tile, int hl, int d) { return tile * 256 + (d >> 5) * 128 + hl * 32 + (d & 31); }
__host__ __device__ __forceinline__ int map_win(int n) {
    if (n < 512) { const int hq = n >> 6; return map_rope(hq >> 2, hq & 3, n & 63); }
    if (n < 640) return 3 * 256 + (n - 512);
    if (n < 768) return 3 * 256 + 128 + (n - 640);
    if (n < 896) { const int c = n - 768; return map_rope(2, c >> 6, c & 63); }
    if (n < 1024) return 4 * 256 + (n - 896);
    if (n < 1152) { const int c = n - 1024; return map_rope(2, 2 + (c >> 6), c & 63); }
    if (n < 1280) return 4 * 256 + 128 + (n - 1152);
    if (n < 1304) return 17 * 256 + (n - 1280);
    if (n < 2328) return 5 * 256 + (n - 1304);
    if (n < 3352) return 9 * 256 + (n - 2328);
    return 13 * 256 + (n - 3352);
}

DI void row_scales8(const float* ssq, int rowb, int fq, float (&rs)[8]) {
    f32x4 p[8];
#pragma unroll
    for (int i = 0; i < 8; ++i) p[i] = *(const f32x4*)(ssq + (size_t)(rowb + (i >> 2) * 128 + (i & 3) * 16) * 16 + 4 * fq);
#pragma unroll
    for (int i = 0; i < 8; ++i) { float s = (p[i].x + p[i].y) + (p[i].z + p[i].w); s += __shfl_xor(s, 16); s += __shfl_xor(s, 32); rs[i] = rsqrtf(s * (1.0f / 1024.0f) + EPS); }
    asm volatile("" ::: "memory");
}
#define EPI_FENCE() asm volatile("" ::: "memory")

typedef const f32x4 (&AccRef)[2][2][4][2];

struct EpiGateUp {
    static constexpr bool PERM = true, AFTER_DRAIN = false;
    bf16_t* H; const float* ssq;
    DI void operator()(AccRef acc, const pg8::Unit& u, int wr, int wc, int fr, int fq) const {
        const int rowb = u.pm * 256 + wr * 64 + fr; float rs8[8]; row_scales8(ssq, rowb, fq, rs8);
#pragma unroll
        for (int ai = 0; ai < 2; ++ai)
#pragma unroll
            for (int m = 0; m < 4; ++m) {
                const int row = rowb + ai * 128 + m * 16; const float r = rs8[ai * 4 + m]; f32x4 h[2];
#pragma unroll
                for (int n = 0; n < 2; ++n) { const f32x4 g = acc[ai][0][m][n] * r, uu = acc[ai][1][m][n] * r;
                    h[n].x = siluf_(g.x) * uu.x; h[n].y = siluf_(g.y) * uu.y; h[n].z = siluf_(g.z) * uu.z; h[n].w = siluf_(g.w) * uu.w; }
                *(u32x4*)(H + (size_t)row * DFF + u.pn * 128 + wc * 32 + 8 * fq) = pack8(h[0], h[1]);
                EPI_FENCE();
            }
    }
};

struct EpiResid {
    static constexpr bool PERM = true, AFTER_DRAIN = false;
    float* X; bf16_t* XG; const float* gn; float* ssq; float scale;
    DI void operator()(AccRef acc, const pg8::Unit& u, int wr, int wc, int fr, int fq) const {
        const int rowb = u.pm * 256 + wr * 64 + fr, colb = u.pn * 256 + wc * 32 + 8 * fq;
        f32x4 gv[2][2];
#pragma unroll
        for (int bj = 0; bj < 2; ++bj)
#pragma unroll
            for (int n = 0; n < 2; ++n) gv[bj][n] = *(const f32x4*)(gn + colb + bj * 128 + 4 * n);
        f32x4 cur[2][2], nxt[2][2];
        { const float* xp = X + (size_t)rowb * DM + colb;
          cur[0][0] = *(const f32x4*)xp; cur[0][1] = *(const f32x4*)(xp + 4); cur[1][0] = *(const f32x4*)(xp + 128); cur[1][1] = *(const f32x4*)(xp + 132); }
#pragma unroll
        for (int it = 0; it < 8; ++it) {
            const int row = rowb + (it >> 2) * 128 + (it & 3) * 16; float ss = 0.f;
            if (it < 7) { const float* xp = X + (size_t)(rowb + ((it + 1) >> 2) * 128 + ((it + 1) & 3) * 16) * DM + colb;
                nxt[0][0] = *(const f32x4*)xp; nxt[0][1] = *(const f32x4*)(xp + 4); nxt[1][0] = *(const f32x4*)(xp + 128); nxt[1][1] = *(const f32x4*)(xp + 132); }
#pragma unroll
            for (int bj = 0; bj < 2; ++bj) {
                float* xp = X + (size_t)row * DM + colb + bj * 128;
                const f32x4 x0 = cur[bj][0] + acc[it >> 2][bj][it & 3][0] * scale, x1 = cur[bj][1] + acc[it >> 2][bj][it & 3][1] * scale;
                *(f32x4*)xp = x0; *(f32x4*)(xp + 4) = x1;
                ss += (x0.x * x0.x + x0.y * x0.y) + (x0.z * x0.z + x0.w * x0.w) + (x1.x * x1.x + x1.y * x1.y) + (x1.z * x1.z + x1.w * x1.w);
                *(u32x4*)(XG + (size_t)row * DM + colb + bj * 128) = pack8(x0 * gv[bj][0], x1 * gv[bj][1]);
            }
            ss += __shfl_xor(ss, 16); ss += __shfl_xor(ss, 32);
            if (fq == 0) ssq[(size_t)row * 16 + u.pn * 4 + wc] = ss;
            EPI_FENCE();
            if (it < 7) { cur[0][0] = nxt[0][0]; cur[0][1] = nxt[0][1]; cur[1][0] = nxt[1][0]; cur[1][1] = nxt[1][1]; }
        }
    }
};

struct EpiProj {
    static constexpr bool PERM = true, AFTER_DRAIN = false;
    bf16_t* SGA; bf16_t* SGB; int second;
    DI void operator()(AccRef acc, const pg8::Unit& u, int wr, int wc, int fr, int fq) const {
        const int rowb = u.pm * 256 + wr * 64 + fr, colb = u.pn * 256 + wc * 32 + 8 * fq;
        u32x4 ga[2], gb[2], na[2], nb[2];
        { const size_t off = (size_t)rowb * DM + colb; ga[0] = *(const u32x4*)(SGA + off); ga[1] = *(const u32x4*)(SGA + off + 128);
          if (second) { gb[0] = *(const u32x4*)(SGB + off); gb[1] = *(const u32x4*)(SGB + off + 128); } }
#pragma unroll
        for (int it = 0; it < 8; ++it) {
            const int row = rowb + (it >> 2) * 128 + (it & 3) * 16;
            if (it < 7) { const size_t off = (size_t)(rowb + ((it + 1) >> 2) * 128 + ((it + 1) & 3) * 16) * DM + colb;
                na[0] = *(const u32x4*)(SGA + off); na[1] = *(const u32x4*)(SGA + off + 128);
                if (second) { nb[0] = *(const u32x4*)(SGB + off); nb[1] = *(const u32x4*)(SGB + off + 128); } }
#pragma unroll
            for (int bj = 0; bj < 2; ++bj) {
                const size_t off = (size_t)row * DM + colb + bj * 128;
                const f32x4 a0 = acc[it >> 2][bj][it & 3][0], a1 = acc[it >> 2][bj][it & 3][1];
                const u32x4 g = ga[bj];
                if (!second) {
                    f32x4 t0, t1; t0.x = bflo(g.x) * a0.x; t0.y = bfhi(g.x) * a0.y; t0.z = bflo(g.y) * a0.z; t0.w = bfhi(g.y) * a0.w;
                    t1.x = bflo(g.z) * a1.x; t1.y = bfhi(g.z) * a1.y; t1.z = bflo(g.w) * a1.z; t1.w = bfhi(g.w) * a1.w;
                    *(u32x4*)(SGA + off) = pack8(t0, t1);
                } else {
                    const u32x4 h = gb[bj];
                    f32x4 t0, t1; t0.x = bflo(g.x) + bflo(h.x) * a0.x; t0.y = bfhi(g.x) + bfhi(h.x) * a0.y; t0.z = bflo(g.y) + bflo(h.y) * a0.z; t0.w = bfhi(g.y) + bfhi(h.y) * a0.w;
                    t1.x = bflo(g.z) + bflo(h.z) * a1.x; t1.y = bfhi(g.z) + bfhi(h.z) * a1.y; t1.z = bflo(g.w) + bflo(h.w) * a1.z; t1.w = bfhi(g.w) + bfhi(h.w) * a1.w;
                    *(u32x4*)(SGB + off) = pack8(t0, t1);
                }
            }
            EPI_FENCE();
            if (it < 7) { ga[0] = na[0]; ga[1] = na[1]; if (second) { gb[0] = nb[0]; gb[1] = nb[1]; } }
        }
    }
};

struct EpiF32 {
    static constexpr bool PERM = true, AFTER_DRAIN = false;
    float* Y; int ldc;
    DI void operator()(AccRef acc, const pg8::Unit& u, int wr, int wc, int fr, int fq) const {
        const int rowb = u.pm * 256 + wr * 64 + fr, colb = u.pn * 256 + wc * 32 + 8 * fq;
#pragma unroll
        for (int ai = 0; ai < 2; ++ai)
#pragma unroll
            for (int m = 0; m < 4; ++m)
#pragma unroll
                for (int bj = 0; bj < 2; ++bj) {
                    float* yp = Y + (size_t)(rowb + ai * 128 + m * 16) * ldc + colb + bj * 128;
                    *(f32x4*)yp = acc[ai][bj][m][0]; *(f32x4*)(yp + 4) = acc[ai][bj][m][1];
                }
    }
};

struct EpiWin {
    static constexpr bool PERM = true, AFTER_DRAIN = false;
    unsigned char* ws; const float* sgn;
    DI void operator()(AccRef acc, const pg8::Unit& u, int wr, int wc, int fr, int fq) const {
        const float* ssq = (const float*)(ws + WS_SSQ); bf16_t* Q = (bf16_t*)(ws + WS_Q); bf16_t* KSEL = (bf16_t*)(ws + WS_KSEL); bf16_t* KWIN = (bf16_t*)(ws + WS_KWIN);
        bf16_t* KC = (bf16_t*)(ws + WS_KC); bf16_t* VC = (bf16_t*)(ws + WS_VC); bf16_t* VSELT = (bf16_t*)(ws + WS_VSELT); bf16_t* VWINT = (bf16_t*)(ws + WS_VWINT);
        bf16_t* U = (bf16_t*)(ws + WS_U); bf16_t* VPT = (bf16_t*)(ws + WS_VPT); bf16_t* SGA = (bf16_t*)(ws + WS_SGA); bf16_t* SGB = (bf16_t*)(ws + WS_SGB);
        float* GN = (float*)(ws + WS_GN); float* ssqv = (float*)(ws + WS_SSQV); const float* cs = (const float*)(ws + WS_CS); const float* sn = (const float*)(ws + WS_SN);
        const int rowb = u.pm * 256 + wr * 64 + fr, pn = u.pn; float rs8[8]; row_scales8(ssq, rowb, fq, rs8);
        if (pn <= 2) {
#pragma unroll
            for (int ai = 0; ai < 2; ++ai)
#pragma unroll
                for (int m = 0; m < 4; ++m) {
                    const int row = rowb + ai * 128 + m * 16, pos = row & (SEQ - 1), bb = row >> 13; const float r = rs8[ai * 4 + m];
                    const float* cp = cs + pos * 32 + 8 * fq; const float* sp = sn + pos * 32 + 8 * fq;
                    f32x4 o1[2], o2[2];
#pragma unroll
                    for (int n = 0; n < 2; ++n) { const f32x4 c = *(const f32x4*)(cp + 4 * n), s = *(const f32x4*)(sp + 4 * n);
                        const f32x4 x1 = acc[ai][0][m][n] * r, x2 = acc[ai][1][m][n] * r; o1[n] = x1 * c - x2 * s; o2[n] = x2 * c + x1 * s;
                        if (pn < 2) { o1[n] = o1[n] * C2; o2[n] = o2[n] * C2; } }
                    bf16_t* dst;
                    if (pn < 2) dst = Q + (size_t)row * 512 + pn * 256 + wc * 64 + 8 * fq;
                    else dst = (wc < 2 ? KSEL : KWIN) + ((size_t)(bb * 2 + (wc & 1)) * SEQ + pos) * 64 + 8 * fq;
                    *(u32x4*)dst = pack8(o1[0], o1[1]); *(u32x4*)(dst + 32) = pack8(o2[0], o2[1]);
                }
        } else if (pn == 3) {
#pragma unroll
            for (int ai = 0; ai < 2; ++ai)
#pragma unroll
                for (int m = 0; m < 4; ++m) {
                    const int row = rowb + ai * 128 + m * 16, pos = row & (SEQ - 1), bb = row >> 13; const float r = rs8[ai * 4 + m];
#pragma unroll
                    for (int bj = 0; bj < 2; ++bj)
                        *(u32x4*)((bj ? VC : KC) + ((size_t)(bb * 2 + (wc >> 1)) * SEQ + pos) * 64 + (wc & 1) * 32 + 8 * fq) = pack8(acc[ai][bj][m][0] * r, acc[ai][bj][m][1] * r);
                }
        } else if (pn == 4) {
#pragma unroll
            for (int ai = 0; ai < 2; ++ai)
#pragma unroll
                for (int m = 0; m < 4; ++m) {
                    const int row = rowb + ai * 128 + m * 16, pos = row & (SEQ - 1), bb = row >> 13; const float r = rs8[ai * 4 + m];
#pragma unroll
                    for (int bj = 0; bj < 2; ++bj) {
                        bf16_t* base = (bj ? VWINT : VSELT) + (((size_t)(bb * 2 + (wc >> 1)) * 128 + (pos >> 6)) * 64 + (wc & 1) * 32 + 8 * fq) * 64 + (pos & 63);
#pragma unroll
                        for (int n = 0; n < 2; ++n) { const f32x4 v = acc[ai][bj][m][n] * r;
                            base[(4 * n + 0) * 64] = f2bf(v.x); base[(4 * n + 1) * 64] = f2bf(v.y); base[(4 * n + 2) * 64] = f2bf(v.z); base[(4 * n + 3) * 64] = f2bf(v.w); }
                    }
                }
        } else if (pn <= 6) {
#pragma unroll
            for (int ai = 0; ai < 2; ++ai)
#pragma unroll
                for (int m = 0; m < 4; ++m) {
                    const int row = rowb + ai * 128 + m * 16; const float r = rs8[ai * 4 + m];
#pragma unroll
                    for (int bj = 0; bj < 2; ++bj) { f32x4 g[2];
#pragma unroll
                        for (int n = 0; n < 2; ++n) { const f32x4 v = acc[ai][bj][m][n] * r; g[n].x = gelu_tanh(v.x); g[n].y = gelu_tanh(v.y); g[n].z = gelu_tanh(v.z); g[n].w = gelu_tanh(v.w); }
                        *(u32x4*)(U + (size_t)row * 512 + (pn - 5) * 256 + bj * 128 + wc * 32 + 8 * fq) = pack8(g[0], g[1]); }
                }
        } else if (pn <= 8) {
#pragma unroll
            for (int ai = 0; ai < 2; ++ai)
#pragma unroll
                for (int m = 0; m < 4; ++m) {
                    const int row = rowb + ai * 128 + m * 16; const float r = rs8[ai * 4 + m]; float ss = 0.f;
#pragma unroll
                    for (int bj = 0; bj < 2; ++bj) {
                        const int col0 = (pn - 7) * 256 + bj * 128 + wc * 32 + 8 * fq;
                        bf16_t* base = VPT + ((size_t)(row >> 7) * 512 + col0) * 128 + (row & 127);
#pragma unroll
                        for (int n = 0; n < 2; ++n) { const f32x4 v = acc[ai][bj][m][n] * r; const f32x4 gw = *(const f32x4*)(sgn + col0 + 4 * n);
                            const float g0 = gelu_tanh(v.x), g1 = gelu_tanh(v.y), g2 = gelu_tanh(v.z), g3 = gelu_tanh(v.w);
                            ss += (g0 * g0 + g1 * g1) + (g2 * g2 + g3 * g3);
                            base[(4 * n + 0) * 128] = f2bf(g0 * gw.x); base[(4 * n + 1) * 128] = f2bf(g1 * gw.y); base[(4 * n + 2) * 128] = f2bf(g2 * gw.z); base[(4 * n + 3) * 128] = f2bf(g3 * gw.w); }
                    }
                    ss += __shfl_xor(ss, 16); ss += __shfl_xor(ss, 32);
                    if (fq == 0) ssqv[(size_t)row * 8 + (pn - 7) * 4 + wc] = ss;
                }
        } else if (pn <= 16) {
            bf16_t* G = (pn <= 12) ? SGA + (pn - 9) * 256 : SGB + (pn - 13) * 256;
#pragma unroll
            for (int ai = 0; ai < 2; ++ai)
#pragma unroll
                for (int m = 0; m < 4; ++m) {
                    const int row = rowb + ai * 128 + m * 16; const float r = rs8[ai * 4 + m];
#pragma unroll
                    for (int bj = 0; bj < 2; ++bj) { f32x4 g[2];
#pragma unroll
                        for (int n = 0; n < 2; ++n) { const f32x4 v = acc[ai][bj][m][n] * r; g[n].x = sigmoidf_(v.x); g[n].y = sigmoidf_(v.y); g[n].z = sigmoidf_(v.z); g[n].w = sigmoidf_(v.w); }
                        *(u32x4*)(G + (size_t)row * DM + bj * 128 + wc * 32 + 8 * fq) = pack8(g[0], g[1]); }
                }
        } else {
            if (wc == 0) {
#pragma unroll
                for (int ai = 0; ai < 2; ++ai)
#pragma unroll
                    for (int m = 0; m < 4; ++m) {
                        const int row = rowb + ai * 128 + m * 16; const float r = rs8[ai * 4 + m];
#pragma unroll
                        for (int n = 0; n < 2; ++n) { const f32x4 v = acc[ai][0][m][n] * r; f32x4 g; g.x = sigmoidf_(v.x); g.y = sigmoidf_(v.y); g.z = sigmoidf_(v.z); g.w = sigmoidf_(v.w);
                            *(f32x4*)(GN + (size_t)row * 32 + 8 * fq + 4 * n) = g; }
                    }
            }
        }
    }
};

DI void transpose_item(const float* W, int K, int N, bf16_t* WT, int mode, int rowoff, LAS float* scr, int item, int lane) {
    const int nblk = (N + 63) >> 6, kb = item / nblk, nb = item % nblk, k0 = 64 * kb, n0 = 64 * nb;
    const int nn = n0 + 4 * (lane & 15);
    f32x4 v[16];
#pragma unroll
    for (int i = 0; i < 16; ++i) { const int kk = 4 * i + (lane >> 4); v[i] = (nn < N) ? *(const f32x4*)(W + (size_t)(k0 + kk) * N + nn) : (f32x4){0.f, 0.f, 0.f, 0.f}; }
#pragma unroll
    for (int i = 0; i < 16; ++i) { const int kk = 4 * i + (lane >> 4); LAS float* d = scr + kk * 65 + 4 * (lane & 15); d[0] = v[i].x; d[1] = v[i].y; d[2] = v[i].z; d[3] = v[i].w; }
    asm volatile("s_waitcnt lgkmcnt(0)" ::: "memory");
    const int c = lane & 7;
#pragma unroll
    for (int j = 0; j < 8; ++j) {
        const int n = (lane >> 3) + 8 * j; const LAS float* s = scr + (8 * c) * 65 + n;
        if (n0 + n < N) {
            const int src = n0 + n; const int row = rowoff + (mode == 1 ? map_gateup(src) : (mode == 2 ? map_win(src) : src));
            u32x4 o; o.x = pk2(s[0 * 65], s[1 * 65]); o.y = pk2(s[2 * 65], s[3 * 65]); o.z = pk2(s[4 * 65], s[5 * 65]); o.w = pk2(s[6 * 65], s[7 * 65]);
            *(u32x4*)(WT + (size_t)row * K + k0 + 8 * c) = o;
        }
    }
    asm volatile("s_waitcnt lgkmcnt(0)" ::: "memory");
}

struct Params { const float* in[22]; float* out; unsigned char* ws; };

DI void convert_early(const Params& P, int l, lds_u8* L, int gw, int ngw, int wave, int lane) {
    LAS float* scr = (LAS float*)(L + wave * 16640);
    unsigned char* wb = P.ws + ((l & 1) ? W_ALT : 0);
    constexpr int I_GU = 16 * 88, I_D = 44 * 16, I_IN = 16 * 69, I_W1 = 16 * 4;
    constexpr int NITEMS = I_GU + I_D + I_IN + 4 * I_W1;
    for (int it = gw; it < NITEMS; it += ngw) {
        int r = it;
        if (r < I_GU) { transpose_item(P.in[2] + (size_t)l * DM * NGU, DM, NGU, (bf16_t*)(wb + W_GU1), 1, 0, scr, r, lane); continue; } r -= I_GU;
        if (r < I_D) { transpose_item(P.in[3] + (size_t)l * DFF * DM, DFF, DM, (bf16_t*)(wb + W_D1), 0, 0, scr, r, lane); continue; } r -= I_D;
        if (r < I_IN) { transpose_item(P.in[5] + (size_t)l * DM * NINS, DM, NINS, (bf16_t*)(wb + W_IN), 2, 0, scr, r, lane); continue; } r -= I_IN;
        if (r < I_W1) { transpose_item(P.in[8] + (size_t)l * 2048 * 256, 1024, 256, (bf16_t*)(wb + W_1K), 0, 0, scr, r, lane); continue; } r -= I_W1;
        if (r < I_W1) { transpose_item(P.in[8] + (size_t)l * 2048 * 256 + 1024 * 256, 1024, 256, (bf16_t*)(wb + W_1K), 0, 256, scr, r, lane); continue; } r -= I_W1;
        if (r < I_W1) { transpose_item(P.in[10] + (size_t)l * 2048 * 256, 1024, 256, (bf16_t*)(wb + W_1V), 0, 0, scr, r, lane); continue; } r -= I_W1;
        transpose_item(P.in[10] + (size_t)l * 2048 * 256 + 1024 * 256, 1024, 256, (bf16_t*)(wb + W_1V), 0, 256, scr, r, lane);
    }
}
DI void convert_late(const Params& P, int l, lds_u8* L, int gw, int ngw, int wave, int lane) {
    LAS float* scr = (LAS float*)(L + wave * 16640);
    unsigned char* ws = P.ws;
    constexpr int I_GU = 16 * 88, I_D = 44 * 16, I_P = 8 * 16, I_WO = 16 * 16;
    constexpr int NITEMS = I_GU + I_D + 2 * I_P + I_WO;
    for (int it = gw; it < NITEMS; it += ngw) {
        int r = it;
        if (r < I_GU) { transpose_item(P.in[19] + (size_t)l * DM * NGU, DM, NGU, (bf16_t*)(ws + W_GU2), 1, 0, scr, r, lane); continue; } r -= I_GU;
        if (r < I_D) { transpose_item(P.in[20] + (size_t)l * DFF * DM, DFF, DM, (bf16_t*)(ws + W_D2), 0, 0, scr, r, lane); continue; } r -= I_D;
        if (r < I_P) { transpose_item(P.in[15] + (size_t)l * 512 * DM, 512, DM, (bf16_t*)(ws + W_PA), 0, 0, scr, r, lane); continue; } r -= I_P;
        if (r < I_P) { transpose_item(P.in[16] + (size_t)l * 512 * DM, 512, DM, (bf16_t*)(ws + W_PB), 0, 0, scr, r, lane); continue; } r -= I_P;
        transpose_item(P.in[17] + (size_t)l * DM * DM, DM, DM, (bf16_t*)(ws + W_WO), 0, 0, scr, r, lane);
    }
}

DI void prologue_phase(const Params& P, lds_u8* L, int gw, int ngw, int tid, int lane) {
    unsigned char* ws = P.ws;
    const float* x = P.in[0]; const float* gn = P.in[1];
    bf16_t* XG = (bf16_t*)(ws + WS_XG); float* ssq = (float*)(ws + WS_SSQ);
    f32x4 g4[4];
#pragma unroll
    for (int j = 0; j < 4; ++j) g4[j] = *((const f32x4*)gn + lane + 64 * j);
    for (int row = gw; row < MT; row += ngw) {
        const f32x4* xr = (const f32x4*)(x + (size_t)row * DM) + lane; f32x4* orow = (f32x4*)(P.out + (size_t)row * DM) + lane;
        u32x2* xg = (u32x2*)(XG + (size_t)row * DM) + lane;
        float s = 0.f;
#pragma unroll
        for (int j = 0; j < 4; ++j) { const f32x4 v = xr[64 * j]; s += (v.x * v.x + v.y * v.y) + (v.z * v.z + v.w * v.w); orow[64 * j] = v;
            const f32x4 w = v * g4[j]; u32x2 o; o.x = pk2(w.x, w.y); o.y = pk2(w.z, w.w); xg[64 * j] = o; }
        s = wave_sum(s);
        if (lane < 16) ssq[(size_t)row * 16 + lane] = (lane == 0) ? s : 0.f;
    }
    float* cs = (float*)(ws + WS_CS); float* sn = (float*)(ws + WS_SN);
    const int gtid = blockIdx.x * 512 + tid, ngt = gridDim.x * 512;
    for (int i = gtid; i < SEQ * 32; i += ngt) {
        const int pos = i >> 5, k = i & 31;
        const float inv = __builtin_amdgcn_exp2f(-(float)k * (13.287712379549449f / 32.0f));
        const float ang = (float)pos * inv;
        const double rev = (double)ang * 0.15915494309189535; const float fr = (float)(rev - floor(rev));
        cs[i] = __builtin_amdgcn_cosf(fr); sn[i] = __builtin_amdgcn_sinf(fr);
    }
}

DI void bias_phase(const Params& P, int l, lds_u8* L, int tid, int rank) {
    if (rank >= 0 && rank < 16) {
        const int kv = rank >> 3, cgp = rank & 7;
        const float* pe = P.in[kv ? 7 : 6] + (size_t)l * 2048; const float* w1 = P.in[kv ? 10 : 8] + (size_t)l * 2048 * 256;
        const int c = cgp * 32 + (tid & 31), ksl = tid >> 5; float a = 0.f;
#pragma unroll 8
        for (int k = ksl * 128; k < ksl * 128 + 128; ++k) a += pe[k] * w1[(size_t)k * 256 + c];
        LAS float* red = (LAS float*)L;
        __syncthreads();
        red[tid] = a; __syncthreads();
        if (tid < 32) { float s = 0.f;
#pragma unroll
            for (int i = 0; i < 16; ++i) s += red[i * 32 + tid];
            ((float*)(P.ws + WS_BIAS))[(l * 2 + kv) * 256 + cgp * 32 + tid] = s; }
        __syncthreads();
    }
}

#define MFMA32(a, b, c) __builtin_amdgcn_mfma_f32_32x32x16_bf16((a), (b), (c), 0, 0, 0)
DI f32x16 zero16() { f32x16 z; for (int i = 0; i < 16; ++i) z[i] = 0.f; return z; }

DI void sgu_phase(const Params& P, int l, lds_u8* L, int tid, int wave, int lane, int rank, int nrank) {
    unsigned char* ws = P.ws;
    const float* wsg = P.in[13] + (size_t)l * 8 * 128 * 128 + (size_t)wave * 128 * 128; const float* bs = P.in[14] + (size_t)l * 8 * 128 + wave * 128;
    const bf16_t* VPT = (const bf16_t*)(ws + WS_VPT); const bf16_t* U = (const bf16_t*)(ws + WS_U); bf16_t* YB = (bf16_t*)(ws + WS_YB);
    const float* ssqv = (const float*)(ws + WS_SSQV);
    LAS float* rsv = (LAS float*)L;
    const int rho = lane & 31, hh = lane >> 5;
    if (rank >= 0) for (int c = rank; c < MT / 128; c += nrank) {
        __syncthreads();
        if (tid < 128) { const float* p = ssqv + (size_t)(c * 128 + tid) * 8; float s = 0.f;
#pragma unroll
            for (int i = 0; i < 8; ++i) s += p[i];
            rsv[tid] = rsqrtf(s * (1.0f / 512.0f) + EPS); }
        __syncthreads();
        const bf16_t* vb = VPT + ((size_t)c * 512 + wave * 64) * 128;
#pragma unroll
        for (int tt = 0; tt < 4; ++tt) {
            f32x16 a0 = zero16(), a1 = zero16();
            const int t = 32 * tt + rho;
            const float* wrow = wsg + (size_t)t * 128;
            const int nks = 2 * (tt + 1);
#pragma unroll
            for (int ks = 0; ks < nks; ++ks) {
                const int s0 = 16 * ks + 8 * hh;
                const f32x4 w0 = *(const f32x4*)(wrow + s0), w1 = *(const f32x4*)(wrow + s0 + 4);
                float wv[8] = {w0.x, w0.y, w0.z, w0.w, w1.x, w1.y, w1.z, w1.w};
#pragma unroll
                for (int j = 0; j < 8; ++j) wv[j] = (s0 + j <= t) ? wv[j] * rsv[s0 + j] : 0.f;
                u32x4 bw; bw.x = pk2(wv[0], wv[1]); bw.y = pk2(wv[2], wv[3]); bw.z = pk2(wv[4], wv[5]); bw.w = pk2(wv[6], wv[7]);
                const bf16x8 bfrag = __builtin_bit_cast(bf16x8, bw);
                const bf16x8 af0 = *(const bf16x8*)(vb + (size_t)rho * 128 + s0), af1 = *(const bf16x8*)(vb + (size_t)(32 + rho) * 128 + s0);
                a0 = MFMA32(af0, bfrag, a0); a1 = MFMA32(af1, bfrag, a1);
            }
            const float bias = bs[t]; const size_t tok = (size_t)c * 128 + t;
#pragma unroll
            for (int dt = 0; dt < 2; ++dt)
#pragma unroll
                for (int q4 = 0; q4 < 4; ++q4) {
                    const int d = wave * 64 + 32 * dt + 8 * q4 + 4 * hh;
                    const u32x2 uu = *(const u32x2*)(U + tok * 512 + d);
                    const f32x16& a = dt ? a1 : a0;
                    u32x2 o; o.x = pk2(bflo(uu.x) * (a[4 * q4 + 0] + bias), bfhi(uu.x) * (a[4 * q4 + 1] + bias)); o.y = pk2(bflo(uu.y) * (a[4 * q4 + 2] + bias), bfhi(uu.y) * (a[4 * q4 + 3] + bias));
                    *(u32x2*)(YB + tok * 512 + d) = o;
                }
        }
    }
}

DI void cmp2_phase(const Params& P, int l, lds_u8* L, int tid, int wave, int lane) {
    unsigned char* ws = P.ws;
    LAS float* hid = (LAS float*)L;
    const float* cs = (const float*)(ws + WS_CS); const float* sn = (const float*)(ws + WS_SN);
    for (int u = blockIdx.x; u < 512; u += gridDim.x) {
        const int kv = u >> 8, bg = (u >> 5) & 7, ng = u & 31;
        const float* Y = (const float*)(ws + (kv ? WS_YV : WS_YK)); const float* bias = (const float*)(ws + WS_BIAS) + (l * 2 + kv) * 256;
        const float* w2 = P.in[kv ? 11 : 9] + (size_t)l * 256 * 64;
        __syncthreads();
        { LAS f32x4* w2l4 = (LAS f32x4*)(L + 16384); const f32x4* w2g = (const f32x4*)w2;
#pragma unroll
          for (int i = 0; i < 8; ++i) w2l4[tid + 512 * i] = w2g[tid + 512 * i]; }
#pragma unroll
        for (int i = 0; i < 8; ++i) {
            const int idx = tid + 512 * i, r = idx >> 8, c = idx & 255, n = 16 * ng + r; const size_t jrow = (size_t)bg * 512 + n;
            float v = Y[jrow * 512 + c] + bias[c]; if (n < 511) v += Y[(jrow + 1) * 512 + 256 + c];
            hid[r * 256 + c] = gelu_tanh(v);
        }
        __syncthreads();
        float a0 = 0.f, a1 = 0.f; const LAS float* h0 = hid + (2 * wave) * 256; const LAS float* h1 = h0 + 256;
        const LAS float* w2l = (const LAS float*)(L + 16384) + lane;
#pragma unroll 16
        for (int k = 0; k < 256; ++k) { const float w = w2l[k * 64]; a0 += h0[k] * w; a1 += h1[k] * w; }
#pragma unroll
        for (int rr = 0; rr < 2; ++rr) {
            const int n = 16 * ng + 2 * wave + rr; float a = rr ? a1 : a0;
            if (kv == 0) {
                const float pr = __shfl_xor(a, 32); const int pos = 16 * n + 31; float o = 0.f;
                if (n < 511) { const float c = cs[pos * 32 + (lane & 31)], s = sn[pos * 32 + (lane & 31)]; o = (lane < 32) ? a * c - pr * s : a * c + pr * s; }
                ((bf16_t*)(ws + WS_KCMP))[((size_t)bg * 512 + n) * 64 + lane] = f2bf(o);
            } else {
                if (n >= 511) a = 0.f;
                ((bf16_t*)(ws + WS_VCMPT))[(((size_t)bg * 8 + (n >> 6)) * 64 + lane) * 64 + (n & 63)] = f2bf(a);
            }
        }
    }
}

constexpr int A_KB = 0, A_VB = 32768, A_IMP = 65536, IMPW = 132, A_SELM = A_IMP + 64 * IMPW * 4;
constexpr int A_QF = A_SELM + 1024;
static_assert(A_QF + 32768 <= XB_ST_OFF, "attention LDS map");
constexpr size_t WS_OF = WS_YK;

DI void attn_load(const bf16_t* kt, const bf16_t* vt, int wave, int lane, u32x4& kr, u32x4& vr) {
    kr = *(const u32x4*)(kt + lane * 64 + wave * 8); vr = *(const u32x4*)(vt + lane * 64 + wave * 8);
}
DI void attn_store(lds_u8* L, int ofs, int wave, int lane, const u32x4& kr, const u32x4& vr) {
    const int slot = (lane & ~12) | ((lane & 4) << 1) | ((lane & 8) >> 1);
    *(LAS u32x4*)(L + A_KB + ofs + wave * 1024 + slot * 16) = kr;
    *(LAS u32x4*)(L + A_VB + ofs + wave * 1024 + lane * 16) = vr;
}
DI f32x16 splat16(float v) { f32x16 z; for (int i = 0; i < 16; ++i) z[i] = v; return z; }
DI void qk_tile(lds_u8* L, int ofs, const lds_u8* qfl, int rho, int hh, float cinit, f32x16& s0, f32x16& s1) {
    const f32x16 cv = splat16(cinit);
#pragma unroll
    for (int c = 0; c < 4; ++c) {
        const lds_u8* kb = L + A_KB + ofs + (2 * c + hh) * 1024 + rho * 16;
        const bf16x8 k0 = *(const LAS bf16x8*)kb, k1 = *(const LAS bf16x8*)(kb + 512), q = *(const LAS bf16x8*)(qfl + c * 1024);
        if (c == 0) { s0 = MFMA32(k0, q, cv); s1 = MFMA32(k1, q, cv); } else { s0 = MFMA32(k0, q, s0); s1 = MFMA32(k1, q, s1); }
    }
}
DI void qk_tile_r(lds_u8* L, int ofs, const bf16x8 (&qr)[4], int rho, int hh, float cinit, f32x16& s0, f32x16& s1) {
    const f32x16 cv = splat16(cinit);
#pragma unroll
    for (int c = 0; c < 4; ++c) {
        const lds_u8* kb = L + A_KB + ofs + (2 * c + hh) * 1024 + rho * 16;
        const bf16x8 k0 = *(const LAS bf16x8*)kb, k1 = *(const LAS bf16x8*)(kb + 512);
        if (c == 0) { s0 = MFMA32(k0, qr[0], cv); s1 = MFMA32(k1, qr[0], cv); } else { s0 = MFMA32(k0, qr[c], s0); s1 = MFMA32(k1, qr[c], s1); }
    }
}
DI void mask_range(f32x16& s0, f32x16& s1, int hh, int lo, int hi) {
#pragma unroll
    for (int i = 0; i < 16; ++i) { const int k = 16 * (i >> 3) + 8 * hh + (i & 7);
        if (k < lo || k > hi) s0[i] = -INFINITY; if (k + 32 < lo || k + 32 > hi) s1[i] = -INFINITY; }
}
DI float xhalf_max(float a) {
    const unsigned u = __float_as_uint(a);
    auto rr = __builtin_amdgcn_permlane32_swap(u, u, false, false);
    return fmaxf(__uint_as_float(rr[0]), __uint_as_float(rr[1]));
}
DI float tile_max_lane(const f32x16& s0, const f32x16& s1) {
    float a = fmaxf(fmaxf(s0[0], s1[0]), s0[1]), b = fmaxf(fmaxf(s1[1], s0[2]), s1[2]);
#pragma unroll
    for (int i = 3; i < 15; i += 2) { a = fmaxf(fmaxf(a, s0[i]), s1[i]); b = fmaxf(fmaxf(b, s0[i + 1]), s1[i + 1]); }
    a = fmaxf(fmaxf(a, s0[15]), s1[15]); return fmaxf(a, b);
}
DI void pv_tile(lds_u8* L, int ofs, const f32x16& p0, const f32x16& p1, int rho, int hh, f32x16& o0, f32x16& o1) {
#pragma unroll
    for (int sub = 0; sub < 2; ++sub)
#pragma unroll
        for (int s = 0; s < 2; ++s) {
            const f32x16& p = sub ? p1 : p0;
            u32x4 w; w.x = pk2(p[8 * s + 0], p[8 * s + 1]); w.y = pk2(p[8 * s + 2], p[8 * s + 3]); w.z = pk2(p[8 * s + 4], p[8 * s + 5]); w.w = pk2(p[8 * s + 6], p[8 * s + 7]);
            const bf16x8 pf = __builtin_bit_cast(bf16x8, w);
            const lds_u8* vb = L + A_VB + ofs + (2 * (2 * sub + s) + hh) * 1024 + rho * 16;
            const bf16x8 v0 = *(const LAS bf16x8*)vb, v1 = *(const LAS bf16x8*)(vb + 512);
            o0 = MFMA32(v0, pf, o0); o1 = MFMA32(v1, pf, o1);
        }
}

template <int MODE>
DI void tile_range(int tt, int t_hi, int qb, int ql, int nmax, u64 sel_lo, u64 sel_hi, int& lo, int& hi) {
    lo = 0; hi = 63;
    const int tq = (tt <= t_hi) ? tt : 0;
    if (MODE <= 1) hi = nmax - 64 * tq;
    if (MODE == 2) { const u64 wsel = (tq < 64) ? (sel_lo >> tq) : (sel_hi >> (tq - 64)); hi = (wsel & 1ull) ? ((tq == qb) ? ql : 63) : -1; }
    if (MODE == 3) { if (tq == qb) hi = ql; if (tq == qb - 8) lo = ql + 1; }
    if (hi > 63) hi = 63;
    if (tt > t_hi) hi = -1;
}
DI float quad_xor1(float v) { return __int_as_float(__builtin_amdgcn_update_dpp(0, __float_as_int(v), 0xB1, 0xF, 0xF, true)); }
DI float quad_xor2(float v) { return __int_as_float(__builtin_amdgcn_update_dpp(0, __float_as_int(v), 0x4E, 0xF, 0xF, true)); }
DI void imp_accum(const f32x16& s0, const f32x16& s1, int tt, int rho, int hh, LAS float* improw, float& carry) {
    float a[4], b[4], x[4];
#pragma unroll
    for (int r = 0; r < 4; ++r) {
        const f32x16& p = (r >> 1) ? s1 : s0; const int o = 8 * (r & 1);
        a[r] = p[o + 0] + p[o + 1] + p[o + 2] + 0.5f * p[o + 3];
        b[r] = 0.5f * p[o + 3] + p[o + 4] + p[o + 5] + p[o + 6] + 0.5f * p[o + 7];
        x[r] = __shfl_xor(0.5f * p[o + 7], 32);
    }
    float E[4];
    E[0] = a[0] + (hh ? x[0] : carry);
#pragma unroll
    for (int r = 1; r < 4; ++r) E[r] = a[r] + (hh ? x[r] : x[r - 1]);
    carry = x[3];
#pragma unroll
    for (int r = 0; r < 4; ++r) { E[r] += quad_xor1(E[r]); E[r] += quad_xor2(E[r]); b[r] += quad_xor1(b[r]); b[r] += quad_xor2(b[r]); }
    if ((rho & 3) == 0) { LAS float* d = improw + 16 * tt + 2 * hh;
#pragma unroll
        for (int r = 0; r < 4; ++r) { d[4 * r] = E[r]; d[4 * r + 1] = b[r]; } }
}
template <int MODE>
DI void attn_run(lds_u8* L, const bf16_t* Kb, const bf16_t* Vb, int t_lo, int t_hi, const lds_u8* qf, int wave, int lane, int qb, int ql, int nmax,
                 u64 sel_lo, u64 sel_hi, float& m, float& l, int& started, f32x16& o0, f32x16& o1, float inv_l, LAS float* improw) {
    const int rho = lane & 31, hh = lane >> 5;
    const int npair = (t_hi - t_lo + 2) >> 1;
    float icarry = 0.f;
    u32x4 kr0, vr0, kr1, vr1;
    { const int tb0 = (t_lo + 1 <= t_hi) ? t_lo + 1 : t_lo;
      attn_load(Kb + (size_t)t_lo * 4096, Vb + (size_t)t_lo * 4096, wave, lane, kr0, vr0);
      attn_load(Kb + (size_t)tb0 * 4096, Vb + (size_t)tb0 * 4096, wave, lane, kr1, vr1); }
    attn_store(L, 0, wave, lane, kr0, vr0); attn_store(L, 8192, wave, lane, kr1, vr1);
    __syncthreads();
    int st = 0;
    for (int pi = 0; pi < npair; ++pi) {
        const int ta = t_lo + 2 * pi, tb = ta + 1;
        const bool more = pi + 1 < npair;
        if (more) { const int na = ta + 2, nb = (ta + 3 <= t_hi) ? ta + 3 : t_lo;
            attn_load(Kb + (size_t)na * 4096, Vb + (size_t)na * 4096, wave, lane, kr0, vr0);
            attn_load(Kb + (size_t)nb * 4096, Vb + (size_t)nb * 4096, wave, lane, kr1, vr1); }
        int loA, hiA, loB, hiB;
        tile_range<MODE>(ta, t_hi, qb, ql, nmax, sel_lo, sel_hi, loA, hiA);
        tile_range<MODE>(tb, t_hi, qb, ql, nmax, sel_lo, sel_hi, loB, hiB);
        const bool actA = (hiA >= loA) && (hiA >= 0), actB = (hiB >= loB) && (hiB >= 0);
        if (__ballot(actA || actB) == 0ull) icarry = 0.f;
        if (__ballot(actA || actB) != 0ull) {
            const int so = st * 16384;
            f32x16 a0, a1, b0, b1;
            qk_tile(L, so, qf, rho, hh, actA ? -m : -INFINITY, a0, a1);
            asm volatile("" ::: "memory");
            qk_tile(L, so + 8192, qf, rho, hh, actB ? -m : -INFINITY, b0, b1);
            asm volatile("" ::: "memory");
            if (__ballot(actA && (loA > 0 || hiA < 63)) != 0ull) mask_range(a0, a1, hh, loA, hiA);
            if (__ballot(actB && (loB > 0 || hiB < 63)) != 0ull) mask_range(b0, b1, hh, loB, hiB);
            if (MODE != 1) {
                float rm = fmaxf(tile_max_lane(a0, a1), tile_max_lane(b0, b1)); rm = xhalf_max(rm);
                float delta = 0.f; bool first = false;
                if (rm > -INFINITY) { if (!started) { delta = rm; first = true; started = 1; } else if (rm > 8.f) delta = rm; }
                if (__ballot(delta != 0.f) != 0ull) {
                    m += delta; const float f = first ? 1.0f : __builtin_amdgcn_exp2f(-delta); l *= f;
#pragma unroll
                    for (int i = 0; i < 16; ++i) { a0[i] -= delta; a1[i] -= delta; b0[i] -= delta; b1[i] -= delta; if (MODE >= 2) { o0[i] *= f; o1[i] *= f; } }
                }
                float sum = 0.f, sum2 = 0.f;
#pragma unroll
                for (int i = 0; i < 16; ++i) { a0[i] = __builtin_amdgcn_exp2f(a0[i]); a1[i] = __builtin_amdgcn_exp2f(a1[i]); sum += a0[i] + a1[i]; }
#pragma unroll
                for (int i = 0; i < 16; ++i) { b0[i] = __builtin_amdgcn_exp2f(b0[i]); b1[i] = __builtin_amdgcn_exp2f(b1[i]); sum2 += b0[i] + b1[i]; }
                l += sum + sum2;
                if (MODE >= 2) { pv_tile(L, so, a0, a1, rho, hh, o0, o1); asm volatile("" ::: "memory"); pv_tile(L, so + 8192, b0, b1, rho, hh, o0, o1); }
            } else {
#pragma unroll
                for (int i = 0; i < 16; ++i) { a0[i] = __builtin_amdgcn_exp2f(a0[i]) * inv_l; a1[i] = __builtin_amdgcn_exp2f(a1[i]) * inv_l;
                                               b0[i] = __builtin_amdgcn_exp2f(b0[i]) * inv_l; b1[i] = __builtin_amdgcn_exp2f(b1[i]) * inv_l; }
                pv_tile(L, so, a0, a1, rho, hh, o0, o1); asm volatile("" ::: "memory"); pv_tile(L, so + 8192, b0, b1, rho, hh, o0, o1);
                imp_accum(a0, a1, ta, rho, hh, improw, icarry);
                if (tb <= t_hi) imp_accum(b0, b1, tb, rho, hh, improw, icarry);
            }
        }
        if (more) { attn_store(L, (st ^ 1) * 16384, wave, lane, kr0, vr0); attn_store(L, (st ^ 1) * 16384 + 8192, wave, lane, kr1, vr1); }
        __syncthreads();
        st ^= 1;
    }
}

DI void pv_packed(lds_u8* L, int ofs, const u32x4 (&pw)[4], int rho, int hh, f32x16& o0, f32x16& o1) {
#pragma unroll
    for (int c16 = 0; c16 < 4; ++c16) {
        const bf16x8 pf = __builtin_bit_cast(bf16x8, pw[c16]);
        const lds_u8* vb = L + A_VB + ofs + (2 * c16 + hh) * 1024 + rho * 16;
        const bf16x8 v0 = *(const LAS bf16x8*)vb, v1 = *(const LAS bf16x8*)(vb + 512);
        o0 = MFMA32(v0, pf, o0); o1 = MFMA32(v1, pf, o1);
    }
}
template <int MODE>
DI void attn_stag(lds_u8* L, const bf16_t* Kb, const bf16_t* Vb, int t_lo, int t_hi, const lds_u8* qf, int wave, int lane, int qb, int ql,
                  u64 sel_lo, u64 sel_hi, float& m, float& l, int& started, f32x16& o0, f32x16& o1) {
    const int rho = lane & 31, hh = lane >> 5;
    const bool late = wave >= 4;
    bf16x8 qr[4];
#pragma unroll
    for (int c = 0; c < 4; ++c) qr[c] = *(const LAS bf16x8*)(qf + c * 1024);
    u32x4 kr, vr;
    attn_load(Kb + (size_t)t_lo * 4096, Vb + (size_t)t_lo * 4096, wave, lane, kr, vr);
    { const int slot = (lane & ~12) | ((lane & 4) << 1) | ((lane & 8) >> 1);
      *(LAS u32x4*)(L + A_KB + wave * 1024 + slot * 16) = kr; *(LAS u32x4*)(L + A_VB + wave * 1024 + lane * 16) = vr; }
    __syncthreads();
    u32x4 pw[4]; bool havep = false; int vprev = 0, ks = 0, vs = 0;
    for (int tt = t_lo; tt <= t_hi; ++tt) {
        const bool more = tt < t_hi;
        if (more) attn_load(Kb + (size_t)(tt + 1) * 4096, Vb + (size_t)(tt + 1) * 4096, wave, lane, kr, vr);
        int lo, hi; tile_range<MODE>(tt, t_hi, qb, ql, 0, sel_lo, sel_hi, lo, hi);
        const bool act = (hi >= lo) && (hi >= 0);
        if (late && havep) { pv_packed(L, vprev * 8192, pw, rho, hh, o0, o1); havep = false; }
        if (__ballot(act) != 0ull) {
            f32x16 s0, s1; qk_tile_r(L, ks * 8192, qr, rho, hh, act ? -m : -INFINITY, s0, s1);
            asm volatile("" ::: "memory");
            if (__ballot(act && (lo > 0 || hi < 63)) != 0ull) mask_range(s0, s1, hh, lo, hi);
            float rm = tile_max_lane(s0, s1); rm = xhalf_max(rm);
            float delta = 0.f; bool first = false;
            if (rm > -INFINITY) { if (!started) { delta = rm; first = true; started = 1; } else if (rm > 8.f) delta = rm; }
            if (__ballot(delta != 0.f) != 0ull) {
                m += delta; const float f = first ? 1.0f : __builtin_amdgcn_exp2f(-delta); l *= f;
#pragma unroll
                for (int i = 0; i < 16; ++i) { s0[i] -= delta; s1[i] -= delta; o0[i] *= f; o1[i] *= f; }
            }
            float sum = 0.f;
#pragma unroll
            for (int i = 0; i < 16; ++i) { s0[i] = __builtin_amdgcn_exp2f(s0[i]); s1[i] = __builtin_amdgcn_exp2f(s1[i]); sum += s0[i]; sum += s1[i]; }
            l += sum;
#pragma unroll
            for (int c16 = 0; c16 < 4; ++c16) { const f32x16& p = (c16 >> 1) ? s1 : s0; const int b8 = 8 * (c16 & 1);
                pw[c16].x = pk2(p[b8 + 0], p[b8 + 1]); pw[c16].y = pk2(p[b8 + 2], p[b8 + 3]); pw[c16].z = pk2(p[b8 + 4], p[b8 + 5]); pw[c16].w = pk2(p[b8 + 6], p[b8 + 7]); }
            if (!late) pv_packed(L, vs * 8192, pw, rho, hh, o0, o1); else { havep = true; vprev = vs; }
        }
        const int ks1 = ks ^ 1, vs1 = (vs == 2) ? 0 : vs + 1;
        if (more) { const int slot = (lane & ~12) | ((lane & 4) << 1) | ((lane & 8) >> 1);
            *(LAS u32x4*)(L + A_KB + ks1 * 8192 + wave * 1024 + slot * 16) = kr; *(LAS u32x4*)(L + A_VB + vs1 * 8192 + wave * 1024 + lane * 16) = vr; }
        __syncthreads();
        ks = ks1; vs = vs1;
    }
    if (late && havep) pv_packed(L, vprev * 8192, pw, rho, hh, o0, o1);
    __syncthreads();
}

DI void attn_phase(const Params& P, lds_u8* L, int tid, int wave, int lane) {
    unsigned char* ws = P.ws;
    const bf16_t* Q = (const bf16_t*)(ws + WS_Q); const float* GN = (const float*)(ws + WS_GN); bf16_t* YA = (bf16_t*)(ws + WS_YA);
    const int rho = lane & 31, hh = lane >> 5, hd = rho & 3;
    LAS float* improw = (LAS float*)(L + A_IMP) + (wave * 8 + (rho >> 2)) * IMPW;
    LAS float* impw = (LAS float*)(L + A_IMP) + wave * 8 * IMPW;
    LAS u64* selm = (LAS u64*)(L + A_SELM);
    f32x4* ofl = (f32x4*)(ws + WS_OF) + ((size_t)blockIdx.x * 512 + tid) * 8;
    for (int u = blockIdx.x; u < 1024; u += gridDim.x) {
        const int iq = u >> 8, v = u & 255, bg = v & 7, sI = v >> 3;
        const int qb = (iq == 0) ? sI : (iq == 1) ? 63 - sI : (iq == 2) ? 64 + sI : 127 - sI;
        const int b = bg >> 1, g = bg & 1;
        const int ql = 8 * wave + (rho >> 2), t = 64 * qb + ql; const size_t tok = (size_t)b * SEQ + t;
        lds_u8* qf = L + A_QF + wave * 4096 + lane * 16;
#pragma unroll
        for (int c = 0; c < 4; ++c) *(LAS bf16x8*)(qf + c * 1024) = *(const bf16x8*)(Q + tok * 512 + g * 256 + hd * 64 + 16 * c + 8 * hh);
        for (int i = lane; i < 8 * IMPW; i += 64) impw[i] = 0.f;
        const bf16_t* Kc = (const bf16_t*)(ws + WS_KCMP) + (size_t)bg * 512 * 64; const bf16_t* Vc = (const bf16_t*)(ws + WS_VCMPT) + (size_t)bg * 512 * 64;
        const bf16_t* Ks = (const bf16_t*)(ws + WS_KSEL) + (size_t)bg * SEQ * 64; const bf16_t* Vs = (const bf16_t*)(ws + WS_VSELT) + (size_t)bg * SEQ * 64;
        const bf16_t* Kw = (const bf16_t*)(ws + WS_KWIN) + (size_t)bg * SEQ * 64; const bf16_t* Vw = (const bf16_t*)(ws + WS_VWINT) + (size_t)bg * SEQ * 64;
        const int nmax = (t - 31) >> 4;
        const int tc_hi = (4 * qb + 2) >> 6;
        f32x16 of0, of1, o0, o1; float m, l; int started;
#ifdef DUP_CMP
        for (int rep_ = 0; rep_ < 2; ++rep_) {
        if (rep_) { asm volatile("" :: "v"(o0), "v"(o1)); for (int i = lane; i < 8 * IMPW; i += 64) impw[i] = 0.f; }
#endif
        m = 0.f; l = 0.f; started = 0; o0 = zero16(); o1 = zero16();
        attn_run<0>(L, Kc, Vc, 0, tc_hi, qf, wave, lane, qb, ql, nmax, 0ull, 0ull, m, l, started, o0, o1, 0.f, improw);
        l += __shfl_xor(l, 32);
        const float inv_l = (l > 0.f) ? 1.0f / l : 0.f;
        attn_run<1>(L, Kc, Vc, 0, tc_hi, qf, wave, lane, qb, ql, nmax, 0ull, 0ull, m, l, started, o0, o1, inv_l, improw);
#pragma unroll
        for (int i = 0; i < 4; ++i) { const float gc = GN[tok * 32 + (g * 4 + hd) * 3 + 0];
            ofl[i] = (f32x4){gc * o0[4 * i], gc * o0[4 * i + 1], gc * o0[4 * i + 2], gc * o0[4 * i + 3]}; ofl[4 + i] = (f32x4){gc * o1[4 * i], gc * o1[4 * i + 1], gc * o1[4 * i + 2], gc * o1[4 * i + 3]}; }
        if (qb > 15) {
            const bool cand0 = lane < qb, cand1 = lane + 64 < qb; const u64 ltm = (1ull << lane) - 1ull;
            for (int qi = 0; qi < 8; ++qi) {
                const LAS float* row = impw + qi * IMPW;
                const unsigned k0 = cand0 ? __float_as_uint(row[lane]) : 0u, k1 = cand1 ? __float_as_uint(row[lane + 64]) : 0u;
                unsigned prefix = 0u;
                for (int bit = 30; bit >= 0; --bit) {
                    const unsigned trial = prefix | (1u << bit);
                    const int cnt = __popcll(__ballot(cand0 && k0 >= trial)) + __popcll(__ballot(cand1 && k1 >= trial));
                    if (cnt >= 15) prefix = trial;
                }
                const u64 gt0 = __ballot(cand0 && k0 > prefix), gt1 = __ballot(cand1 && k1 > prefix);
                const u64 eq0 = __ballot(cand0 && k0 == prefix), eq1 = __ballot(cand1 && k1 == prefix);
                const int need = 15 - (__popcll(gt0) + __popcll(gt1));
                const int r0 = __popcll(eq0 & ltm), r1 = __popcll(eq0) + __popcll(eq1 & ltm);
                const bool s0 = (lane == qb) || (cand0 && (k0 > prefix || (k0 == prefix && r0 < need)));
                const bool s1 = (lane + 64 == qb) || (cand1 && (k1 > prefix || (k1 == prefix && r1 < need)));
                const u64 m0 = __ballot(s0), m1 = __ballot(s1);
                if (lane == 0) { selm[(wave * 8 + qi) * 2] = m0; selm[(wave * 8 + qi) * 2 + 1] = m1; }
            }
        } else {
            if (lane < 8) { selm[(wave * 8 + lane) * 2] = (1ull << (qb + 1)) - 1ull; selm[(wave * 8 + lane) * 2 + 1] = 0ull; }
        }
        const u64 sel_lo = selm[(wave * 8 + (rho >> 2)) * 2], sel_hi = selm[(wave * 8 + (rho >> 2)) * 2 + 1];
        m = 0.f; l = 0.f; started = 0; o0 = zero16(); o1 = zero16();
        attn_stag<2>(L, Ks, Vs, 0, qb, qf, wave, lane, qb, ql, sel_lo, sel_hi, m, l, started, o0, o1);
#ifdef DUP_SEL
        asm volatile("" :: "v"(o0), "v"(o1), "v"(l), "v"(m));
        m = 0.f; l = 0.f; started = 0; o0 = zero16(); o1 = zero16();
        attn_stag<2>(L, Ks, Vs, 0, qb, qf, wave, lane, qb, ql, sel_lo, sel_hi, m, l, started, o0, o1);
#endif
        l += __shfl_xor(l, 32);
        { const float f = GN[tok * 32 + (g * 4 + hd) * 3 + 1] / l;
#pragma unroll
          for (int i = 0; i < 4; ++i) { ofl[i] = ofl[i] + (f32x4){f * o0[4 * i], f * o0[4 * i + 1], f * o0[4 * i + 2], f * o0[4 * i + 3]}; ofl[4 + i] = ofl[4 + i] + (f32x4){f * o1[4 * i], f * o1[4 * i + 1], f * o1[4 * i + 2], f * o1[4 * i + 3]}; } }
        m = 0.f; l = 0.f; started = 0; o0 = zero16(); o1 = zero16();
        attn_stag<3>(L, Kw, Vw, (qb >= 8) ? qb - 8 : 0, qb, qf, wave, lane, qb, ql, 0ull, 0ull, m, l, started, o0, o1);
        l += __shfl_xor(l, 32);
        { const float f = GN[tok * 32 + (g * 4 + hd) * 3 + 2] / l;
#pragma unroll
          for (int i = 0; i < 4; ++i) { const f32x4 pa = ofl[i], pb = ofl[4 + i];
            of0[4 * i] = pa.x + f * o0[4 * i]; of0[4 * i + 1] = pa.y + f * o0[4 * i + 1]; of0[4 * i + 2] = pa.z + f * o0[4 * i + 2]; of0[4 * i + 3] = pa.w + f * o0[4 * i + 3];
            of1[4 * i] = pb.x + f * o1[4 * i]; of1[4 * i + 1] = pb.y + f * o1[4 * i + 1]; of1[4 * i + 2] = pb.z + f * o1[4 * i + 2]; of1[4 * i + 3] = pb.w + f * o1[4 * i + 3]; } }
        bf16_t* yo = YA + tok * 512 + (g * 4 + hd) * 64 + 4 * hh;
#pragma unroll
        for (int q4 = 0; q4 < 4; ++q4) {
            u32x2 a; a.x = pk2(of0[4 * q4 + 0], of0[4 * q4 + 1]); a.y = pk2(of0[4 * q4 + 2], of0[4 * q4 + 3]); *(u32x2*)(yo + 8 * q4) = a;
            u32x2 c; c.x = pk2(of1[4 * q4 + 0], of1[4 * q4 + 1]); c.y = pk2(of1[4 * q4 + 2], of1[4 * q4 + 3]); *(u32x2*)(yo + 32 + 8 * q4) = c;
        }
    }
}

DI void final_phase(const Params& P, int gw, int ngw, int lane) {
    const float* ssq = (const float*)(P.ws + WS_SSQ); const float* gn = P.in[21];
    f32x4 g4[4];
#pragma unroll
    for (int j = 0; j < 4; ++j) g4[j] = *((const f32x4*)gn + lane + 64 * j);
    for (int row = gw; row < MT; row += ngw) {
        float s = (lane < 16) ? ssq[(size_t)row * 16 + lane] : 0.f; s = wave_sum(s);
        const float r = rsqrtf(s * (1.0f / 1024.0f) + EPS);
        f32x4* xr = (f32x4*)(P.out + (size_t)row * DM) + lane;
#pragma unroll
        for (int j = 0; j < 4; ++j) xr[64 * j] = xr[64 * j] * g4[j] * r;
    }
}

#define GEMM(EPI, A_, B_, M_, N_, K_, CID, E_) do { pg8::Gemm g_{(const bf16_t*)(A_), (const bf16_t*)(B_), (M_), (N_), (K_)}; pg8::StaticOrder S_; S_.init((M_), (N_), G, (CID)); \
    pg8::gemm_phase<EPI, pg8::StaticOrder, true, true>(L, g_, S_, (E_)); } while (0)
struct RevOrder {
    pg8::StaticOrder S; int cnt;
    __device__ __forceinline__ void init(int M, int N, int G_, int c_) { S.init(M, N, G_, c_); cnt = (S.nwg > c_) ? (S.nwg - c_ + G_ - 1) / G_ : 0; }
    __device__ __forceinline__ bool next(int i, pg8::Unit& u) const { return (i < cnt) && S.next(cnt - 1 - i, u); }
    __device__ __forceinline__ void a_ready(const pg8::Unit&) const {}
    __device__ __forceinline__ void done(const pg8::Unit&) const {}
};
#define GEMMR(EPI, A_, B_, M_, N_, K_, CID, E_) do { pg8::Gemm g_{(const bf16_t*)(A_), (const bf16_t*)(B_), (M_), (N_), (K_)}; RevOrder S_; S_.init((M_), (N_), G, (CID)); \
    pg8::gemm_phase<EPI, RevOrder, true, true>(L, g_, S_, (E_)); } while (0)

DI const Params& getP() { auto p = __builtin_amdgcn_kernarg_segment_ptr(); asm volatile("" : "+s"(p)); return *(const Params*)p; }

__global__ void __launch_bounds__(512, 2) mega_fwd(Params Pk) {
    extern __shared__ __attribute__((aligned(16))) unsigned char lds_raw[];
    lds_u8* L = (lds_u8*)lds_raw;
#ifndef PM
#define PM 0xFFFF
#endif
#define PHASE_BEGIN const Params& P = getP(); unsigned char* ws = P.ws; (void)ws; int G = gridDim.x, bid = blockIdx.x; asm volatile("" : "+s"(G), "+s"(bid)); const int ngw = G * 8; (void)ngw; int l = lyr; asm volatile("" : "+s"(l)); (void)l; int tid = threadIdx.x; asm volatile("" : "+v"(tid)); \
    const int lane = tid & 63, wave = __builtin_amdgcn_readfirstlane(tid >> 6), gw = bid * 8 + wave; (void)lane; (void)gw;
#define XP_ float* X = P.out; bf16_t* XG = (bf16_t*)(ws + WS_XG); bf16_t* H = (bf16_t*)(ws + WS_H); float* ssq = (float*)(ws + WS_SSQ); \
    bf16_t* SGA = (bf16_t*)(ws + WS_SGA); bf16_t* SGB = (bf16_t*)(ws + WS_SGB); (void)X; (void)XG; (void)H; (void)ssq; (void)SGA; (void)SGB;

    { LAS unsigned* st0 = (LAS unsigned*)(L + XB_ST_OFF); if (threadIdx.x < 2) st0[threadIdx.x] = 0u; __syncthreads();
      (void)xcd_barrier_post((unsigned*)(getP().ws + WS_CTL), (volatile LAS unsigned*)st0); }
#define XSYNC_ONE() do { XcdBarrier xb_; xb_.bar = (unsigned*)(getP().ws + WS_CTL); xb_.x = xb_xcc_id(); xb_.st = (volatile LAS unsigned*)(L + XB_ST_OFF); xcd_barrier(xb_); } while (0)
#ifdef DUP_SYNC
#define GRID_SYNC() do { XSYNC_ONE(); XSYNC_ONE(); } while (0)
#else
#define GRID_SYNC() XSYNC_ONE()
#endif
    int lyr = 0;
    if (PM & 1) { PHASE_BEGIN prologue_phase(P, L, gw, ngw, tid, lane); }
#ifdef DUP_PRO
    { PHASE_BEGIN prologue_phase(P, L, gw, ngw, tid, lane); }
    { PHASE_BEGIN prologue_phase(P, L, gw, ngw, tid, lane); }
#endif
    __syncthreads();
    if (PM & 2) { PHASE_BEGIN convert_early(P, 0, L, gw, ngw, wave, lane); }
    cg::this_grid().sync();
#pragma nounroll
    for (lyr = 0; lyr < DEPTH; ++lyr) {
#define WB_ (ws + ((l & 1) ? W_ALT : 0))
        if (PM & 4) { PHASE_BEGIN XP_ EpiGateUp E{H, ssq}; GEMM(EpiGateUp, XG, WB_ + W_GU1, MT, NGU, DM, bid, E); }
#ifdef DUP_GU
        GRID_SYNC();
        { PHASE_BEGIN XP_ EpiGateUp E{H, ssq}; GEMM(EpiGateUp, XG, WB_ + W_GU1, MT, NGU, DM, bid, E); }
#endif
        GRID_SYNC();
        if (PM & 8) { PHASE_BEGIN XP_ EpiResid E{X, XG, P.in[4] + l * DM, ssq, 0.5f}; GEMMR(EpiResid, H, WB_ + W_D1, MT, DM, DFF, bid, E); }
        GRID_SYNC();
        if (PM & 16) { PHASE_BEGIN XP_ EpiWin E{ws, P.in[12] + l * 512};
          GEMM(EpiWin, XG, WB_ + W_IN, MT, NINP, DM, bid, E); }
#ifdef DUP_WIN
        GRID_SYNC();
        { PHASE_BEGIN XP_ EpiWin E{ws, P.in[12] + l * 512};
          GEMM(EpiWin, XG, WB_ + W_IN, MT, NINP, DM, bid, E); }
#endif
        GRID_SYNC();
        if (PM & 32) { PHASE_BEGIN EpiF32 E{(float*)(ws + WS_YK), 512}; GEMM(EpiF32, ws + WS_KC, WB_ + W_1K, 4096, 512, 1024, bid, E); }
        if (PM & 32) { PHASE_BEGIN EpiF32 E{(float*)(ws + WS_YV), 512}; GEMM(EpiF32, ws + WS_VC, WB_ + W_1V, 4096, 512, 1024, (bid + G / 2) % G, E); }
#define P4RANK const int rank = bid, nrank = G; (void)nrank;
        if (PM & 64) { PHASE_BEGIN bias_phase(P, l, L, tid, (G >= 64) ? bid - 32 : bid); }
        if (PM & 64) { PHASE_BEGIN P4RANK sgu_phase(P, l, L, tid, wave, lane, rank, nrank); }
        __syncthreads();
        if (PM & 2) { PHASE_BEGIN P4RANK if (rank >= 0) convert_late(P, l, L, rank * 8 + wave, nrank * 8, wave, lane); }
#ifdef DUP_CONV
        { PHASE_BEGIN convert_late(P, l, L, gw, ngw, wave, lane); }
#endif
        GRID_SYNC();
        if (PM & 128) { PHASE_BEGIN cmp2_phase(P, l, L, tid, wave, lane); }
        __syncthreads();
        if (PM & 2) { PHASE_BEGIN if (l + 1 < DEPTH) convert_early(P, l + 1, L, gw, ngw, wave, lane); }
#ifdef DUP_CONV
        { PHASE_BEGIN if (l + 1 < DEPTH) convert_early(P, l + 1, L, gw, ngw, wave, lane); }
#endif
        GRID_SYNC();
        if (PM & 256) { PHASE_BEGIN attn_phase(P, L, tid, wave, lane); }
#ifdef DUP_ATT
        GRID_SYNC();
        { PHASE_BEGIN attn_phase(P, L, tid, wave, lane); }
#endif
        GRID_SYNC();
        if (PM & 512) { PHASE_BEGIN XP_ EpiProj E{SGA, SGB, 0}; GEMM(EpiProj, ws + WS_YA, ws + W_PA, MT, DM, 512, bid, E); }
        if (PM & 512) { PHASE_BEGIN XP_ EpiProj E{SGA, SGB, 1}; GEMM(EpiProj, ws + WS_YB, ws + W_PB, MT, DM, 512, bid, E); }
        GRID_SYNC();
        if (PM & 1024) { PHASE_BEGIN XP_ EpiResid E{X, XG, P.in[18] + l * DM, ssq, 1.0f}; GEMM(EpiResid, SGB, ws + W_WO, MT, DM, DM, bid, E); }
        GRID_SYNC();
        if (PM & 2048) { PHASE_BEGIN XP_ EpiGateUp E{H, ssq}; GEMM(EpiGateUp, XG, ws + W_GU2, MT, NGU, DM, bid, E); }
        GRID_SYNC();
        if (PM & 4096) { PHASE_BEGIN XP_ EpiResid E{X, XG, P.in[1] + ((l + 1 < DEPTH) ? (l + 1) : l) * DM, ssq, 0.5f}; GEMMR(EpiResid, H, ws + W_D2, MT, DM, DFF, bid, E); }
        GRID_SYNC();
    }
    if (PM & 8192) { PHASE_BEGIN final_phase(P, gw, ngw, lane); }
}

extern "C" void kernel_launch(void* const* d_in, const int* in_sizes, int n_in, void* d_out, int out_size, void* d_ws, size_t ws_size, hipStream_t stream) {
    static int grid = 0;
    if (grid == 0) {
        if (n_in != 22 || out_size != MT * DM || ws_size < WS_END) { fprintf(stderr, "kernel_launch: unexpected shapes (n_in %d, out %d, ws %zu)\n", n_in, out_size, ws_size); grid = -1; return; }
        int dev = 0, cus = 0, per_cu = 0;
        hipGetDevice(&dev); hipDeviceGetAttribute(&cus, hipDeviceAttributeMultiprocessorCount, dev);
        hipFuncSetAttribute((const void*)mega_fwd, hipFuncAttributeMaxDynamicSharedMemorySize, LDS_BYTES);
        hipOccupancyMaxActiveBlocksPerMultiprocessor(&per_cu, (const void*)mega_fwd, 512, LDS_BYTES);
        (void)hipGetLastError();
        if (per_cu < 1) per_cu = 1;
        grid = cus * per_cu;
        if (grid > 256) grid = 256;
    }
    if (grid < 0) return;
    if (hipMemsetAsync((char*)d_ws + WS_CTL, 0, 16384, stream) != hipSuccess) { fprintf(stderr, "kernel_launch: memset of barrier words failed\n"); return; }
    Params p{};
    for (int i = 0; i < 22; ++i) p.in[i] = (const float*)d_in[i];
    p.out = (float*)d_out; p.ws = (unsigned char*)d_ws;
    void* args[] = {&p};
    hipError_t e = hipLaunchCooperativeKernel((const void*)mega_fwd, dim3(grid), dim3(512), args, LDS_BYTES, stream);
    if (e != hipSuccess) fprintf(stderr, "cooperative launch failed: %s (grid %d)\n", hipGetErrorString(e), grid);
}
```

```cpp
#include <hip/hip_runtime.h>
#include <hip/hip_cooperative_groups.h>
#include <cstdio>
#include <cstdint>
namespace cg = cooperative_groups;
namespace pg8 {
#define PG8_LAS __attribute__((address_space(3)))
typedef unsigned short bf16_t;
typedef short bf16x8 __attribute__((ext_vector_type(8)));
typedef float f32x4 __attribute__((ext_vector_type(4)));
typedef unsigned u32x4 __attribute__((ext_vector_type(4)));
constexpr int BM = 256, BK = 64, HALF = 128, HTB = HALF * BK * 2  , STAGE_BYTES = 8 * HTB, NXCD = 8, WGM = 8;

__host__ __device__ __forceinline__ int lds_byte(int r, int c) { const int st = (r >> 4) * 2 + (c >> 5), rr = r & 15, cc = c & 31, ob = rr * 64 + cc * 2; return st * 1024 + (ob ^ (((ob >> 9) & 1) << 5)); }
__host__ __device__ __forceinline__ void stage_rc(int b, int& R, int& C) { const int st = b / 1024, sb = b % 1024, swz = sb ^ (((sb >> 9) & 1) << 5); R = (st >> 1) * 16 + swz / 64; C = (st & 1) * 32 + (swz % 64) / 2; }
__host__ __device__ __forceinline__ int perm32(int rho) { const int n = rho >> 4, i = rho & 15; return 8 * (i >> 2) + 4 * n + (i & 3); }

struct Unit { int pm, pn; };
struct Gemm { const bf16_t* A; const bf16_t* Bt; int M, N, K; };

struct StaticOrder {
    int nM, nN, nwg, G, c;
    __host__ __device__ void init(int M, int N, int G_, int c_) { nM = M / BM; nN = N / BM; nwg = nM * nN; G = G_; c = c_; }
    __host__ __device__ bool next(int i, Unit& u) const {
        const long L = (long)i * G + c; if (L >= nwg) return false;
        int wgid = (int)L; { const int q = nwg / NXCD, r = nwg % NXCD, xcd = wgid % NXCD, off = wgid / NXCD; wgid = (xcd < r ? xcd * (q + 1) : r * (q + 1) + (xcd - r) * q) + off; }
        const int nig = WGM * nN, gid = wgid / nig, fm = gid * WGM, gsz = (nM - fm) < WGM ? (nM - fm) : WGM;
        u.pm = fm + ((wgid % nig) % gsz); u.pn = (wgid % nig) / gsz; return true;
    }
    __device__ __forceinline__ void a_ready(const Unit&) const {}
    __device__ __forceinline__ void done(const Unit&) const {}
};
__device__ __forceinline__ unsigned cvt_pk_bf16(float lo, float hi) { unsigned r; asm volatile("v_cvt_pk_bf16_f32 %0, %1, %2" : "=v"(r) : "v"(lo), "v"(hi)); return r; }
typedef float f32x2 __attribute__((ext_vector_type(2)));
template <class Epi, class Sched, bool ALIGN_EPI = false, bool SP2 = false>
__device__ __forceinline__ void gemm_phase(PG8_LAS unsigned char* lds, const Gemm g, const Sched& S, const Epi& E) {
    int tid0_ = threadIdx.x; asm volatile("" : "+v"(tid0_));
    const int tid = tid0_, wid = __builtin_amdgcn_readfirstlane(tid >> 6), lane = tid & 63, wr = wid >> 2, wc = wid & 3, fr = lane & 15, fq = lane >> 4;
    const int K = g.K, nt = K / BK;
    unsigned voffA[2], voffB[2];
#pragma unroll
    for (int i = 0; i < 2; ++i) { int R, C; stage_rc(tid * 16 + i * 8192, R, C); const int Rb = Epi::PERM ? ((R & ~31) + perm32(R & 31)) : R;
        voffA[i] = (unsigned)(R * K + C) * 2u; voffB[i] = (unsigned)(Rb * K + C) * 2u; }
    const size_t kstep = (size_t)(BK * 2);
    const size_t hstep = (size_t)HALF * K * 2;
    const size_t tstep = 2 * hstep;
    const unsigned ldsw = (unsigned)wid * 1024u;
    const int aoff = lds_byte(wr * 64 + fr, fq * 8), boff = lds_byte(wc * 32 + fr, fq * 8);
#define PG8_SA(b, h) (((b) * 2 + (h)) * HTB)
#define PG8_SB(b, h) ((4 + (b) * 2 + (h)) * HTB)
#define PG8_STAGE(bufoff, gbase, voff) do { _Pragma("unroll") for (int _i = 0; _i < 2; ++_i) \
        __builtin_amdgcn_global_load_lds((const unsigned*)((const char*)(gbase) + (voff)[_i]), (PG8_LAS unsigned*)(lds + (bufoff) + ldsw + _i * 8192), 16, 0, 0); } while (0)
#define PG8_LDA(dst, b, h) do { _Pragma("unroll") for (int m = 0; m < 4; ++m) _Pragma("unroll") for (int k = 0; k < 2; ++k) dst[m][k] = *(const PG8_LAS bf16x8*)(lds + PG8_SA(b, h) + aoff + m * 2048 + k * 1024); } while (0)
#define PG8_LDB(dst, b, h) do { _Pragma("unroll") for (int n = 0; n < 2; ++n) _Pragma("unroll") for (int k = 0; k < 2; ++k) dst[n][k] = *(const PG8_LAS bf16x8*)(lds + PG8_SB(b, h) + boff + n * 2048 + k * 1024); } while (0)
#define PG8_MMA(ai, bj, At, Bt) do { __builtin_amdgcn_s_setprio(1); _Pragma("unroll") for (int m = 0; m < 4; ++m) _Pragma("unroll") for (int n = 0; n < 2; ++n) _Pragma("unroll") for (int k = 0; k < 2; ++k) \
        acc[ai][bj][m][n] = __builtin_amdgcn_mfma_f32_16x16x32_bf16(Bt[n][k], At[m][k], acc[ai][bj][m][n], 0, 0, 0); __builtin_amdgcn_s_setprio(0); } while (0)
#define PG8_WAIT_V(n) asm volatile("s_waitcnt vmcnt(" #n ")" ::: "memory")
#define PG8_WAIT_L(n) asm volatile("s_waitcnt lgkmcnt(" #n ")" ::: "memory")
#define PG8_BAR __builtin_amdgcn_s_barrier()
#define PG8_SCHED __builtin_amdgcn_sched_barrier(0)
    Unit cur, nxt; int ui = 0;
    if (!S.next(0, cur)) return;
    f32x4 acc[2][2][4][2];
#pragma unroll
    for (int a = 0; a < 2; ++a)
#pragma unroll
        for (int b = 0; b < 2; ++b)
#pragma unroll
            for (int m = 0; m < 4; ++m)
#pragma unroll
                for (int n = 0; n < 2; ++n) acc[a][b][m][n] = (f32x4){0.f, 0.f, 0.f, 0.f};
    bf16x8 At[4][2], B0[2][2], B1[2][2];
    const char* cA = (const char*)g.A + (size_t)cur.pm * tstep; const char* cB = (const char*)g.Bt + (size_t)cur.pn * tstep;
    S.a_ready(cur);
    if constexpr (SP2) {
        PG8_STAGE(PG8_SB(0, 0), cB, voffB); PG8_STAGE(PG8_SB(0, 1), cB + hstep, voffB); PG8_STAGE(PG8_SA(0, 0), cA, voffA); PG8_STAGE(PG8_SA(0, 1), cA + hstep, voffA);
        if (wr == 1) PG8_BAR;
        PG8_WAIT_V(2); PG8_BAR;
        PG8_STAGE(PG8_SB(1, 0), cB + kstep, voffB); PG8_STAGE(PG8_SA(1, 0), cA + kstep, voffA); PG8_STAGE(PG8_SB(1, 1), cB + hstep + kstep, voffB);
        PG8_WAIT_V(6); PG8_BAR;
    } else {
        PG8_STAGE(PG8_SB(0, 0), cB, voffB); PG8_STAGE(PG8_SA(0, 0), cA, voffA); PG8_STAGE(PG8_SB(0, 1), cB + hstep, voffB); PG8_STAGE(PG8_SA(0, 1), cA + hstep, voffA);
        if (wr == 1) PG8_BAR;
        PG8_WAIT_V(4); PG8_BAR;
        PG8_STAGE(PG8_SB(1, 0), cB + kstep, voffB); PG8_STAGE(PG8_SA(1, 0), cA + kstep, voffA); PG8_STAGE(PG8_SB(1, 1), cB + hstep + kstep, voffB);
        PG8_WAIT_V(6); PG8_BAR;
    }
    for (;;) {
        const bool has_next = S.next(ui + 1, nxt);
        const char* nA = has_next ? (const char*)g.A + (size_t)nxt.pm * tstep : cA; const char* nB = has_next ? (const char*)g.Bt + (size_t)nxt.pn * tstep : cB;
        for (int t = 0; t < nt; t += 2) {
            const bool last = (t == nt - 2);
            const char* a1 = cA + (size_t)(t + 1) * kstep;
            const char* a2 = last ? nA : cA + (size_t)(t + 2) * kstep; const char* b2 = last ? nB : cB + (size_t)(t + 2) * kstep;
            const char* a3 = a2 + kstep; const char* b3 = b2 + kstep;
            if (last && has_next) S.a_ready(nxt);
            if constexpr (SP2) {
            PG8_LDB(B0, 0, 0); PG8_LDB(B1, 0, 1); PG8_SCHED; PG8_LDA(At, 0, 0); PG8_STAGE(PG8_SA(1, 1), a1 + hstep, voffA);
            PG8_WAIT_V(8); PG8_WAIT_L(0); PG8_BAR; PG8_MMA(0, 0, At, B0); PG8_MMA(0, 1, At, B1); PG8_BAR; PG8_SCHED;
            PG8_LDA(At, 0, 1); PG8_STAGE(PG8_SB(0, 0), b2, voffB); PG8_STAGE(PG8_SB(0, 1), b2 + hstep, voffB); PG8_STAGE(PG8_SA(0, 0), a2, voffA);
            PG8_WAIT_V(8); PG8_WAIT_L(0); PG8_BAR; PG8_MMA(1, 0, At, B0); PG8_MMA(1, 1, At, B1); PG8_BAR; PG8_SCHED;
            PG8_LDB(B0, 1, 0); PG8_LDB(B1, 1, 1); PG8_SCHED; PG8_LDA(At, 1, 0); PG8_STAGE(PG8_SA(0, 1), a2 + hstep, voffA);
            PG8_WAIT_V(8); PG8_WAIT_L(0); PG8_BAR; PG8_MMA(0, 0, At, B0); PG8_MMA(0, 1, At, B1); PG8_BAR; PG8_SCHED;
            PG8_LDA(At, 1, 1); PG8_STAGE(PG8_SB(1, 0), b3, voffB); PG8_STAGE(PG8_SB(1, 1), b3 + hstep, voffB); PG8_STAGE(PG8_SA(1, 0), a3, voffA);
            PG8_WAIT_V(8); PG8_WAIT_L(0); PG8_BAR; PG8_MMA(1, 0, At, B0); PG8_MMA(1, 1, At, B1); PG8_BAR; PG8_SCHED;
            } else {
            PG8_LDB(B0, 0, 0); PG8_SCHED; PG8_LDA(At, 0, 0); PG8_STAGE(PG8_SA(1, 1), a1 + hstep, voffA);
            PG8_WAIT_L(8); PG8_BAR; PG8_WAIT_L(0); PG8_MMA(0, 0, At, B0); PG8_BAR; PG8_SCHED;
            PG8_LDB(B1, 0, 1); PG8_STAGE(PG8_SB(0, 0), b2, voffB);
            PG8_BAR; PG8_WAIT_L(0); PG8_MMA(0, 1, At, B1); PG8_BAR;
            PG8_LDA(At, 0, 1); PG8_STAGE(PG8_SA(0, 0), a2, voffA);
            PG8_BAR; PG8_WAIT_L(0); PG8_MMA(1, 0, At, B0); PG8_BAR; PG8_SCHED;
            PG8_STAGE(PG8_SB(0, 1), b2 + hstep, voffB);
            PG8_WAIT_V(6); PG8_BAR; PG8_MMA(1, 1, At, B1); PG8_BAR;
            PG8_LDB(B0, 1, 0); PG8_SCHED; PG8_LDA(At, 1, 0); PG8_STAGE(PG8_SA(0, 1), a2 + hstep, voffA);
            PG8_WAIT_L(8); PG8_BAR; PG8_WAIT_L(0); PG8_MMA(0, 0, At, B0); PG8_BAR; PG8_SCHED;
            PG8_LDB(B1, 1, 1); PG8_STAGE(PG8_SB(1, 0), b3, voffB);
            PG8_BAR; PG8_WAIT_L(0); PG8_MMA(0, 1, At, B1); PG8_BAR;
            PG8_LDA(At, 1, 1); PG8_STAGE(PG8_SA(1, 0), a3, voffA);
            PG8_BAR; PG8_WAIT_L(0); PG8_MMA(1, 0, At, B0); PG8_BAR; PG8_SCHED;
            PG8_STAGE(PG8_SB(1, 1), b3 + hstep, voffB);
            PG8_WAIT_V(6); PG8_BAR; PG8_MMA(1, 1, At, B1); PG8_BAR;
            }
        }
        if constexpr (ALIGN_EPI) { if (wr == 0) PG8_BAR; }
        if constexpr (!Epi::AFTER_DRAIN) { E(acc, cur, wr, wc, fr, fq); S.done(cur); }
        if (!has_next) break;
#pragma unroll
        for (int a = 0; a < 2; ++a)
#pragma unroll
            for (int b = 0; b < 2; ++b)
#pragma unroll
                for (int m = 0; m < 4; ++m)
#pragma unroll
                    for (int n = 0; n < 2; ++n) acc[a][b][m][n] = (f32x4){0.f, 0.f, 0.f, 0.f};
        cur = nxt; cA = nA; cB = nB; ++ui;
        if constexpr (ALIGN_EPI) { if (wr == 1) PG8_BAR; }
    }
    PG8_WAIT_V(0);
    if constexpr (!ALIGN_EPI) { if (wr == 0) PG8_BAR; }
    PG8_BAR;
    if constexpr (Epi::AFTER_DRAIN) { E.fused(acc, cur, wr, wc, fr, fq, lds, wid, lane); S.done(cur); }
#undef PG8_SA
#undef PG8_SB
#undef PG8_STAGE
#undef PG8_LDA
#undef PG8_LDB
#undef PG8_MMA
#undef PG8_WAIT_V
#undef PG8_WAIT_L
#undef PG8_BAR
#undef PG8_SCHED
}
}

#define DI __device__ __forceinline__
#define LAS __attribute__((address_space(3)))
typedef LAS unsigned char lds_u8;
typedef pg8::bf16_t bf16_t;
typedef pg8::bf16x8 bf16x8;
typedef pg8::f32x4 f32x4;
typedef pg8::u32x4 u32x4;
typedef float f32x16 __attribute__((ext_vector_type(16)));
typedef unsigned u32x2 __attribute__((ext_vector_type(2)));
typedef unsigned long long u64;

constexpr int NB = 4, SEQ = 8192, DM = 1024, MT = NB * SEQ, DFF = 2816, NGU = 5632, NINP = 4608, NINS = 4376, DEPTH = 4;
constexpr float EPS = 1e-6f;
constexpr float C2 = 0.125f * 1.4426950408889634f;
constexpr int LDS_BYTES = 143360, XB_ST_OFF = 143360 - 64;

constexpr size_t MiB = 1u << 20;
constexpr size_t W_GU1 = 0, W_D1 = 11 * MiB, W_IN = W_D1 + 11 * MiB / 2, W_1K = W_IN + 9 * MiB, W_1V = W_1K + 1 * MiB,
                 W_GU2 = W_1V + 1 * MiB, W_D2 = W_GU2 + 11 * MiB, W_PA = W_D2 + 11 * MiB / 2, W_PB = W_PA + 1 * MiB, W_WO = W_PB + 1 * MiB;
static_assert(W_WO + 2 * MiB == 48 * MiB, "weight map");
constexpr size_t WS_XG = 48 * MiB, WS_H = 112 * MiB;
constexpr size_t WS_Q = WS_H, WS_KSEL = WS_H + 32 * MiB, WS_KWIN = WS_H + 40 * MiB, WS_KC = WS_H + 48 * MiB, WS_VC = WS_H + 56 * MiB, WS_VSELT = WS_H + 64 * MiB,
                 WS_VWINT = WS_H + 72 * MiB, WS_U = WS_H + 80 * MiB, WS_VPT = WS_H + 112 * MiB, WS_YA = WS_H + 144 * MiB;
constexpr size_t WS_SGA = 288 * MiB, WS_SGB = 352 * MiB, WS_YB = 416 * MiB, WS_SSQ = 448 * MiB, WS_SSQV = 450 * MiB, WS_GN = 451 * MiB, WS_YK = 455 * MiB,
                 WS_YV = 463 * MiB, WS_KCMP = 471 * MiB, WS_VCMPT = 471 * MiB + 512 * 1024, WS_CS = 472 * MiB, WS_SN = 473 * MiB, WS_BIAS = 474 * MiB, W_ALT = 475 * MiB, WS_CTL = 503 * MiB, WS_END = 504 * MiB;

typedef float f32x2_t __attribute__((ext_vector_type(2)));
typedef __bf16 bf16x2_t __attribute__((ext_vector_type(2)));
DI unsigned pk2(float lo, float hi) { f32x2_t v = {lo, hi}; bf16x2_t b = __builtin_convertvector(v, bf16x2_t); return __builtin_bit_cast(unsigned, b); }
DI bf16_t f2bf(float v) { return (bf16_t)(pk2(v, 0.f) & 0xffffu); }
DI float bflo(unsigned w) { return __uint_as_float(w << 16); }
DI float bfhi(unsigned w) { return __uint_as_float(w & 0xffff0000u); }
DI float fexp(float x) { return __builtin_amdgcn_exp2f(x * 1.4426950408889634f); }
DI float sigmoidf_(float x) { return __builtin_amdgcn_rcpf(1.0f + fexp(-x)); }
DI float siluf_(float x) { return x * sigmoidf_(x); }
DI float gelu_tanh(float x) { const float u = 0.7978845608028654f * (x + 0.044715f * x * x * x); return x * sigmoidf_(2.0f * u); }
DI float wave_sum(float v) {
#pragma unroll
    for (int o = 1; o < 64; o <<= 1) v += __shfl_xor(v, o);
    return v;
}
#define XB_TMO      128
#define XB_XCNT(j)  (256  + 64 * (j))
#define XB_XSUB(j)  (1280 + 64 * (j))
#define XB_XGEN(j)  (2304 + 64 * (j))
#define XB_TOP      3328
#define XB_TOPGEN   3392
#define XCD_BAR_WORDS 3456
#define XB_SPIN_CAP (1u << 18)

__device__ __forceinline__ unsigned xb_ld(unsigned* p)              { return __hip_atomic_load(p, __ATOMIC_RELAXED, __HIP_MEMORY_SCOPE_AGENT); }
__device__ __forceinline__ unsigned xb_add(unsigned* p, unsigned v) { return __hip_atomic_fetch_add(p, v, __ATOMIC_RELAXED, __HIP_MEMORY_SCOPE_AGENT); }
__device__ __forceinline__ unsigned xb_xcc_id() { return (unsigned)__builtin_amdgcn_s_getreg((3 << 11) | 20) & 0xFu; }
#define XB_SPIN(cond, bar) do { unsigned _sp = 0; while (cond) { __builtin_amdgcn_s_sleep(1); \
    if ((++_sp & 255u) == 0u) { if (xb_ld(&(bar)[XB_TMO])) break; if (_sp > XB_SPIN_CAP) { atomicAdd(&(bar)[XB_TMO], 1u); break; } } } } while (0)

struct XcdBarrier {
    unsigned* bar; unsigned x;
    volatile LAS unsigned* st;
};

__device__ __forceinline__ XcdBarrier xcd_barrier_post(unsigned* bar, volatile LAS unsigned* st) {
    XcdBarrier b; b.bar = bar; b.x = xb_xcc_id(); b.st = st;
    if (threadIdx.x == 0) (void)xb_add(&bar[XB_XCNT(b.x)], 1u);
    return b;
}
__device__ __forceinline__ void xcd_barrier_complete(unsigned* bar, unsigned x, unsigned& nloc, unsigned& nx) {
    const unsigned G = gridDim.x * gridDim.y * gridDim.z;
    unsigned sum, cnt, mine, sp = 0u;
    for (;;) {
        sum = 0u; cnt = 0u; mine = 0u;
#pragma unroll
        for (unsigned j = 0; j < 16; ++j) { const unsigned c = xb_ld(&bar[XB_XCNT(j)]); sum += c; cnt += (c > 0u) ? 1u : 0u; mine = (j == x) ? c : mine; }
        if (sum == G) break;
        __builtin_amdgcn_s_sleep(1);
        if ((++sp & 255u) == 0u) { if (xb_ld(&bar[XB_TMO])) break; if (sp > XB_SPIN_CAP) { atomicAdd(&bar[XB_TMO], 1u); break; } }
    }
    nloc = mine > 0u ? mine : 1u; nx = cnt > 0u ? cnt : 1u;
}

__device__ __forceinline__ void xcd_barrier(const XcdBarrier& b) {
    asm volatile("s_waitcnt vmcnt(0)" ::: "memory");
    __syncthreads();
    if (threadIdx.x == 0) {
        unsigned* bar = b.bar;
        __builtin_amdgcn_s_waitcnt(0);
        unsigned nloc = b.st[0], nx = b.st[1];
        if (nloc == 0u) { xcd_barrier_complete(bar, b.x, nloc, nx); b.st[0] = nloc; b.st[1] = nx; }
        const unsigned old = xb_add(&bar[XB_XSUB(b.x)], 1u);
        const unsigned gen = old / nloc;
        if (old + 1u == (gen + 1u) * nloc) {
            __builtin_amdgcn_fence(__ATOMIC_RELEASE, "agent");
            asm volatile("s_waitcnt vmcnt(0)" ::: "memory");
            const unsigned og = xb_add(&bar[XB_TOP], 1u);
            const unsigned tg = og / nx;
            if (og + 1u == (tg + 1u) * nx) xb_add(&bar[XB_TOPGEN], 1u);
            else XB_SPIN(xb_ld(&bar[XB_TOPGEN]) == tg, bar);
            __builtin_amdgcn_fence(__ATOMIC_ACQUIRE, "agent");
            xb_add(&bar[XB_XGEN(b.x)], 1u);
            asm volatile("s_waitcnt vmcnt(0)" ::: "memory");
        } else {
            XB_SPIN(xb_ld(&bar[XB_XGEN(b.x)]) == gen, bar);
            __builtin_amdgcn_fence(__ATOMIC_ACQUIRE, "agent");
            asm volatile("s_waitcnt vmcnt(0)" ::: "memory");
        }
    }
    __syncthreads();
}

DI u32x4 pack8(const f32x4 a, const f32x4 b) { u32x4 w; w.x = pk2(a.x, a.y); w.y = pk2(a.z, a.w); w.z = pk2(b.x, b.y); w.w = pk2(b.z, b.w); return w; }

__host__ __device__ __forceinline__ int map_gateup(int n) { const int part = n / DFF, c = n % DFF; return 256 * (c >> 7) + 128 * part + (c & 127); }
__host__ __device__ __forceinline__ int map_rope(int tile, int hl, int d) { return tile * 256 + (d >> 5) * 128 + hl * 32 + (d & 31); }
__host__ __device__ __forceinline__ int map_win(int n) {
    if (n < 512) { const int hq = n >> 6; return map_rope(hq >> 2, hq & 3, n & 63); }
    if (n < 640) return 3 * 256 + (n - 512);
    if (n < 768) return 3 * 256 + 128 + (n - 640);
    if (n < 896) { const int c = n - 768; return map_rope(2, c >> 6, c & 63); }
    if (n < 1024) return 4 * 256 + (n - 896);
    if (n < 1152) { const int c = n - 1024; return map_rope(2, 2 + (c >> 6), c & 63); }
    if (n < 1280) return 4 * 256 + 128 + (n - 1152);
    if (n < 1304) return 17 * 256 + (n - 1280);
    if (n < 2328) return 5 * 256 + (n - 1304);
    if (n < 3352) return 9 * 256 + (n - 2328);
    return 13 * 256 + (n - 3352);
}

DI void row_scales8(const float* ssq, int rowb, int fq, float (&rs)[8]) {
    f32x4 p[8];
#pragma unroll
    for (int i = 0; i < 8; ++i) p[i] = *(const f32x4*)(ssq + (size_t)(rowb + (i >> 2) * 128 + (i & 3) * 16) * 16 + 4 * fq);
#pragma unroll
    for (int i = 0; i < 8; ++i) { float s = (p[i].x + p[i].y) + (p[i].z + p[i].w); s += __shfl_xor(s, 16); s += __shfl_xor(s, 32); rs[i] = rsqrtf(s * (1.0f / 1024.0f) + EPS); }
    asm volatile("" ::: "memory");
}
#define EPI_FENCE() asm volatile("" ::: "memory")

typedef const f32x4 (&AccRef)[2][2][4][2];

struct EpiGateUp {
    static constexpr bool PERM = true, AFTER_DRAIN = false;
    bf16_t* H; const float* ssq;
    DI void operator()(AccRef acc, const pg8::Unit& u, int wr, int wc, int fr, int fq) const {
        const int rowb = u.pm * 256 + wr * 64 + fr; float rs8[8]; row_scales8(ssq, rowb, fq, rs8);
#pragma unroll
        for (int ai = 0; ai < 2; ++ai)
#pragma unroll
            for (int m = 0; m < 4; ++m) {
                const int row = rowb + ai * 128 + m * 16; const float r = rs8[ai * 4 + m]; f32x4 h[2];
#pragma unroll
                for (int n = 0; n < 2; ++n) { const f32x4 g = acc[ai][0][m][n] * r, uu = acc[ai][1][m][n] * r;
                    h[n].x = siluf_(g.x) * uu.x; h[n].y = siluf_(g.y) * uu.y; h[n].z = siluf_(g.z) * uu.z; h[n].w = siluf_(g.w) * uu.w; }
                *(u32x4*)(H + (size_t)row * DFF + u.pn * 128 + wc * 32 + 8 * fq) = pack8(h[0], h[1]);
                EPI_FENCE();
            }
    }
};

struct EpiResid {
    static constexpr bool PERM = true, AFTER_DRAIN = false;
    float* X; bf16_t* XG; const float* gn; float* ssq; float scale;
    DI void operator()(AccRef acc, const pg8::Unit& u, int wr, int wc, int fr, int fq) const {
        const int rowb = u.pm * 256 + wr * 64 + fr, colb = u.pn * 256 + wc * 32 + 8 * fq;
        f32x4 gv[2][2];
#pragma unroll
        for (int bj = 0; bj < 2; ++bj)
#pragma unroll
            for (int n = 0; n < 2; ++n) gv[bj][n] = *(const f32x4*)(gn + colb + bj * 128 + 4 * n);
        f32x4 cur[2][2], nxt[2][2];
        { const float* xp = X + (size_t)rowb * DM + colb;
          cur[0][0] = __builtin_nontemporal_load((const f32x4*)xp); cur[0][1] = __builtin_nontemporal_load((const f32x4*)(xp + 4)); cur[1][0] = __builtin_nontemporal_load((const f32x4*)(xp + 128)); cur[1][1] = __builtin_nontemporal_load((const f32x4*)(xp + 132)); }
#pragma unroll
        for (int it = 0; it < 8; ++it) {
            const int row = rowb + (it >> 2) * 128 + (it & 3) * 16; float ss = 0.f;
            if (it < 7) { const float* xp = X + (size_t)(rowb + ((it + 1) >> 2) * 128 + ((it + 1) & 3) * 16) * DM + colb;
                nxt[0][0] = __builtin_nontemporal_load((const f32x4*)xp); nxt[0][1] = __builtin_nontemporal_load((const f32x4*)(xp + 4)); nxt[1][0] = __builtin_nontemporal_load((const f32x4*)(xp + 128)); nxt[1][1] = __builtin_nontemporal_load((const f32x4*)(xp + 132)); }
#pragma unroll
            for (int bj = 0; bj < 2; ++bj) {
                float* xp = X + (size_t)row * DM + colb + bj * 128;
                const f32x4 x0 = cur[bj][0] + acc[it >> 2][bj][it & 3][0] * scale, x1 = cur[bj][1] + acc[it >> 2][bj][it & 3][1] * scale;
                __builtin_nontemporal_store(x0, (f32x4*)xp); __builtin_nontemporal_store(x1, (f32x4*)(xp + 4));
                ss += (x0.x * x0.x + x0.y * x0.y) + (x0.z * x0.z + x0.w * x0.w) + (x1.x * x1.x + x1.y * x1.y) + (x1.z * x1.z + x1.w * x1.w);
                *(u32x4*)(XG + (size_t)row * DM + colb + bj * 128) = pack8(x0 * gv[bj][0], x1 * gv[bj][1]);
            }
            ss += __shfl_xor(ss, 16); ss += __shfl_xor(ss, 32);
            if (fq == 0) ssq[(size_t)row * 16 + u.pn * 4 + wc] = ss;
            EPI_FENCE();
            if (it < 7) { cur[0][0] = nxt[0][0]; cur[0][1] = nxt[0][1]; cur[1][0] = nxt[1][0]; cur[1][1] = nxt[1][1]; }
        }
    }
};

struct EpiProj {
    static constexpr bool PERM = true, AFTER_DRAIN = false;
    bf16_t* SGA; bf16_t* SGB; int second;
    DI void operator()(AccRef acc, const pg8::Unit& u, int wr, int wc, int fr, int fq) const {
        const int rowb = u.pm * 256 + wr * 64 + fr, colb = u.pn * 256 + wc * 32 + 8 * fq;
        u32x4 ga[2], gb[2], na[2], nb[2];
        { const size_t off = (size_t)rowb * DM + colb; ga[0] = *(const u32x4*)(SGA + off); ga[1] = *(const u32x4*)(SGA + off + 128);
          if (second) { gb[0] = *(const u32x4*)(SGB + off); gb[1] = *(const u32x4*)(SGB + off + 128); } }
#pragma unroll
        for (int it = 0; it < 8; ++it) {
            const int row = rowb + (it >> 2) * 128 + (it & 3) * 16;
            if (it < 7) { const size_t off = (size_t)(rowb + ((it + 1) >> 2) * 128 + ((it + 1) & 3) * 16) * DM + colb;
                na[0] = *(const u32x4*)(SGA + off); na[1] = *(const u32x4*)(SGA + off + 128);
                if (second) { nb[0] = *(const u32x4*)(SGB + off); nb[1] = *(const u32x4*)(SGB + off + 128); } }
#pragma unroll
            for (int bj = 0; bj < 2; ++bj) {
                const size_t off = (size_t)row * DM + colb + bj * 128;
                const f32x4 a0 = acc[it >> 2][bj][it & 3][0], a1 = acc[it >> 2][bj][it & 3][1];
                const u32x4 g = ga[bj];
                if (!second) {
                    f32x4 t0, t1; t0.x = bflo(g.x) * a0.x; t0.y = bfhi(g.x) * a0.y; t0.z = bflo(g.y) * a0.z; t0.w = bfhi(g.y) * a0.w;
                    t1.x = bflo(g.z) * a1.x; t1.y = bfhi(g.z) * a1.y; t1.z = bflo(g.w) * a1.z; t1.w = bfhi(g.w) * a1.w;
                    *(u32x4*)(SGA + off) = pack8(t0, t1);
                } else {
                    const u32x4 h = gb[bj];
                    f32x4 t0, t1; t0.x = bflo(g.x) + bflo(h.x) * a0.x; t0.y = bfhi(g.x) + bfhi(h.x) * a0.y; t0.z = bflo(g.y) + bflo(h.y) * a0.z; t0.w = bfhi(g.y) + bfhi(h.y) * a0.w;
                    t1.x = bflo(g.z) + bflo(h.z) * a1.x; t1.y = bfhi(g.z) + bfhi(h.z) * a1.y; t1.z = bflo(g.w) + bflo(h.w) * a1.z; t1.w = bfhi(g.w) + bfhi(h.w) * a1.w;
                    *(u32x4*)(SGB + off) = pack8(t0, t1);
                }
            }
            EPI_FENCE();
            if (it < 7) { ga[0] = na[0]; ga[1] = na[1]; if (second) { gb[0] = nb[0]; gb[1] = nb[1]; } }
        }
    }
};

struct EpiF32 {
    static constexpr bool PERM = true, AFTER_DRAIN = false;
    float* Y; int ldc;
    DI void operator()(AccRef acc, const pg8::Unit& u, int wr, int wc, int fr, int fq) const {
        const int rowb = u.pm * 256 + wr * 64 + fr, colb = u.pn * 256 + wc * 32 + 8 * fq;
#pragma unroll
        for (int ai = 0; ai < 2; ++ai)
#pragma unroll
            for (int m = 0; m < 4; ++m)
#pragma unroll
                for (int bj = 0; bj < 2; ++bj) {
                    float* yp = Y + (size_t)(rowb + ai * 128 + m * 16) * ldc + colb + bj * 128;
                    *(f32x4*)yp = acc[ai][bj][m][0]; *(f32x4*)(yp + 4) = acc[ai][bj][m][1];
                }
    }
};

struct EpiWin {
    static constexpr bool PERM = true, AFTER_DRAIN = false;
    unsigned char* ws; const float* sgn;
    DI void operator()(AccRef acc, const pg8::Unit& u, int wr, int wc, int fr, int fq) const {
        const float* ssq = (const float*)(ws + WS_SSQ); bf16_t* Q = (bf16_t*)(ws + WS_Q); bf16_t* KSEL = (bf16_t*)(ws + WS_KSEL); bf16_t* KWIN = (bf16_t*)(ws + WS_KWIN);
        bf16_t* KC = (bf16_t*)(ws + WS_KC); bf16_t* VC = (bf16_t*)(ws + WS_VC); bf16_t* VSELT = (bf16_t*)(ws + WS_VSELT); bf16_t* VWINT = (bf16_t*)(ws + WS_VWINT);
        bf16_t* U = (bf16_t*)(ws + WS_U); bf16_t* VPT = (bf16_t*)(ws + WS_VPT); bf16_t* SGA = (bf16_t*)(ws + WS_SGA); bf16_t* SGB = (bf16_t*)(ws + WS_SGB);
        float* GN = (float*)(ws + WS_GN); float* ssqv = (float*)(ws + WS_SSQV); const float* cs = (const float*)(ws + WS_CS); const float* sn = (const float*)(ws + WS_SN);
        const int rowb = u.pm * 256 + wr * 64 + fr, pn = u.pn; float rs8[8]; row_scales8(ssq, rowb, fq, rs8);
        if (pn <= 2) {
#pragma unroll
            for (int ai = 0; ai < 2; ++ai)
#pragma unroll
                for (int m = 0; m < 4; ++m) {
                    const int row = rowb + ai * 128 + m * 16, pos = row & (SEQ - 1), bb = row >> 13; const float r = rs8[ai * 4 + m];
                    const float* cp = cs + pos * 32 + 8 * fq; const float* sp = sn + pos * 32 + 8 * fq;
                    f32x4 o1[2], o2[2];
#pragma unroll
                    for (int n = 0; n < 2; ++n) { const f32x4 c = *(const f32x4*)(cp + 4 * n), s = *(const f32x4*)(sp + 4 * n);
                        const f32x4 x1 = acc[ai][0][m][n] * r, x2 = acc[ai][1][m][n] * r; o1[n] = x1 * c - x2 * s; o2[n] = x2 * c + x1 * s;
                        if (pn < 2) { o1[n] = o1[n] * C2; o2[n] = o2[n] * C2; } }
                    bf16_t* dst;
                    if (pn < 2) dst = Q + (size_t)row * 512 + pn * 256 + wc * 64 + 8 * fq;
                    else dst = (wc < 2 ? KSEL : KWIN) + ((size_t)(bb * 2 + (wc & 1)) * SEQ + pos) * 64 + 8 * fq;
                    *(u32x4*)dst = pack8(o1[0], o1[1]); *(u32x4*)(dst + 32) = pack8(o2[0], o2[1]);
                }
        } else if (pn == 3) {
#pragma unroll
            for (int ai = 0; ai < 2; ++ai)
#pragma unroll
                for (int m = 0; m < 4; ++m) {
                    const int row = rowb + ai * 128 + m * 16, pos = row & (SEQ - 1), bb = row >> 13; const float r = rs8[ai * 4 + m];
#pragma unroll
                    for (int bj = 0; bj < 2; ++bj)
                        *(u32x4*)((bj ? VC : KC) + ((size_t)(bb * 2 + (wc >> 1)) * SEQ + pos) * 64 + (wc & 1) * 32 + 8 * fq) = pack8(acc[ai][bj][m][0] * r, acc[ai][bj][m][1] * r);
                }
        } else if (pn == 4) {
#pragma unroll
            for (int ai = 0; ai < 2; ++ai)
#pragma unroll
                for (int m = 0; m < 4; ++m) {
                    const int row = rowb + ai * 128 + m * 16, pos = row & (SEQ - 1), bb = row >> 13; const float r = rs8[ai * 4 + m];
#pragma unroll
                    for (int bj = 0; bj < 2; ++bj) {
                        bf16_t* base = (bj ? VWINT : VSELT) + (((size_t)(bb * 2 + (wc >> 1)) * 128 + (pos >> 6)) * 64 + (wc & 1) * 32 + 8 * fq) * 64 + (pos & 63);
#pragma unroll
                        for (int n = 0; n < 2; ++n) { const f32x4 v = acc[ai][bj][m][n] * r;
                            base[(4 * n + 0) * 64] = f2bf(v.x); base[(4 * n + 1) * 64] = f2bf(v.y); base[(4 * n + 2) * 64] = f2bf(v.z); base[(4 * n + 3) * 64] = f2bf(v.w); }
                    }
                }
        } else if (pn <= 6) {
#pragma unroll
            for (int ai = 0; ai < 2; ++ai)
#pragma unroll
                for (int m = 0; m < 4; ++m) {
                    const int row = rowb + ai * 128 + m * 16; const float r = rs8[ai * 4 + m];
#pragma unroll
                    for (int bj = 0; bj < 2; ++bj) { f32x4 g[2];
#pragma unroll
                        for (int n = 0; n < 2; ++n) { const f32x4 v = acc[ai][bj][m][n] * r; g[n].x = gelu_tanh(v.x); g[n].y = gelu_tanh(v.y); g[n].z = gelu_tanh(v.z); g[n].w = gelu_tanh(v.w); }
                        *(u32x4*)(U + (size_t)row * 512 + (pn - 5) * 256 + bj * 128 + wc * 32 + 8 * fq) = pack8(g[0], g[1]); }
                }
        } else if (pn <= 8) {
#pragma unroll
            for (int ai = 0; ai < 2; ++ai)
#pragma unroll
                for (int m = 0; m < 4; ++m) {
                    const int row = rowb + ai * 128 + m * 16; const float r = rs8[ai * 4 + m]; float ss = 0.f;
#pragma unroll
                    for (int bj = 0; bj < 2; ++bj) {
                        const int col0 = (pn - 7) * 256 + bj * 128 + wc * 32 + 8 * fq;
                        bf16_t* base = VPT + ((size_t)(row >> 7) * 512 + col0) * 128 + (row & 127);
#pragma unroll
                        for (int n = 0; n < 2; ++n) { const f32x4 v = acc[ai][bj][m][n] * r; const f32x4 gw = *(const f32x4*)(sgn + col0 + 4 * n);
                            const float g0 = gelu_tanh(v.x), g1 = gelu_tanh(v.y), g2 = gelu_tanh(v.z), g3 = gelu_tanh(v.w);
                            ss += (g0 * g0 + g1 * g1) + (g2 * g2 + g3 * g3);
                            base[(4 * n + 0) * 128] = f2bf(g0 * gw.x); base[(4 * n + 1) * 128] = f2bf(g1 * gw.y); base[(4 * n + 2) * 128] = f2bf(g2 * gw.z); base[(4 * n + 3) * 128] = f2bf(g3 * gw.w); }
                    }
                    ss += __shfl_xor(ss, 16); ss += __shfl_xor(ss, 32);
                    if (fq == 0) ssqv[(size_t)row * 8 + (pn - 7) * 4 + wc] = ss;
                }
        } else if (pn <= 16) {
            bf16_t* G = (pn <= 12) ? SGA + (pn - 9) * 256 : SGB + (pn - 13) * 256;
#pragma unroll
            for (int ai = 0; ai < 2; ++ai)
#pragma unroll
                for (int m = 0; m < 4; ++m) {
                    const int row = rowb + ai * 128 + m * 16; const float r = rs8[ai * 4 + m];
#pragma unroll
                    for (int bj = 0; bj < 2; ++bj) { f32x4 g[2];
#pragma unroll
                        for (int n = 0; n < 2; ++n) { const f32x4 v = acc[ai][bj][m][n] * r; g[n].x = sigmoidf_(v.x); g[n].y = sigmoidf_(v.y); g[n].z = sigmoidf_(v.z); g[n].w = sigmoidf_(v.w); }
                        *(u32x4*)(G + (size_t)row * DM + bj * 128 + wc * 32 + 8 * fq) = pack8(g[0], g[1]); }
                }
        } else {
            if (wc == 0) {
#pragma unroll
                for (int ai = 0; ai < 2; ++ai)
#pragma unroll
                    for (int m = 0; m < 4; ++m) {
                        const int row = rowb + ai * 128 + m * 16; const float r = rs8[ai * 4 + m];
#pragma unroll
                        for (int n = 0; n < 2; ++n) { const f32x4 v = acc[ai][0][m][n] * r; f32x4 g; g.x = sigmoidf_(v.x); g.y = sigmoidf_(v.y); g.z = sigmoidf_(v.z); g.w = sigmoidf_(v.w);
                            *(f32x4*)(GN + (size_t)row * 32 + 8 * fq + 4 * n) = g; }
                    }
            }
        }
    }
};

DI void transpose_item(const float* W, int K, int N, bf16_t* WT, int mode, int rowoff, LAS float* scr, int item, int lane) {
    const int nblk = (N + 63) >> 6, kb = item / nblk, nb = item % nblk, k0 = 64 * kb, n0 = 64 * nb;
    const int nn = n0 + 4 * (lane & 15);
    f32x4 v[16];
#pragma unroll
    for (int i = 0; i < 16; ++i) { const int kk = 4 * i + (lane >> 4); v[i] = (nn < N) ? __builtin_nontemporal_load((const f32x4*)(W + (size_t)(k0 + kk) * N + nn)) : (f32x4){0.f, 0.f, 0.f, 0.f}; }
#pragma unroll
    for (int i = 0; i < 16; ++i) { const int kk = 4 * i + (lane >> 4); LAS float* d = scr + kk * 65 + 4 * (lane & 15); d[0] = v[i].x; d[1] = v[i].y; d[2] = v[i].z; d[3] = v[i].w; }
    asm volatile("s_waitcnt lgkmcnt(0)" ::: "memory");
    const int c = lane & 7;
#pragma unroll
    for (int j = 0; j < 8; ++j) {
        const int n = (lane >> 3) + 8 * j; const LAS float* s = scr + (8 * c) * 65 + n;
        if (n0 + n < N) {
            const int src = n0 + n; const int row = rowoff + (mode == 1 ? map_gateup(src) : (mode == 2 ? map_win(src) : src));
            u32x4 o; o.x = pk2(s[0 * 65], s[1 * 65]); o.y = pk2(s[2 * 65], s[3 * 65]); o.z = pk2(s[4 * 65], s[5 * 65]); o.w = pk2(s[6 * 65], s[7 * 65]);
            *(u32x4*)(WT + (size_t)row * K + k0 + 8 * c) = o;
        }
    }
    asm volatile("s_waitcnt lgkmcnt(0)" ::: "memory");
}

struct Params { const float* in[22]; float* out; unsigned char* ws; };

DI void convert_early(const Params& P, int l, lds_u8* L, int gw, int ngw, int wave, int lane) {
    LAS float* scr = (LAS float*)(L + wave * 16640);
    unsigned char* wb = P.ws + ((l & 1) ? W_ALT : 0);
    constexpr int I_GU = 16 * 88, I_D = 44 * 16, I_IN = 16 * 69, I_W1 = 16 * 4;
    constexpr int NITEMS = I_GU + I_D + I_IN + 4 * I_W1;
    for (int it = gw; it < NITEMS; it += ngw) {
        int r = it;
        if (r < I_GU) { transpose_item(P.in[2] + (size_t)l * DM * NGU, DM, NGU, (bf16_t*)(wb + W_GU1), 1, 0, scr, r, lane); continue; } r -= I_GU;
        if (r < I_D) { transpose_item(P.in[3] + (size_t)l * DFF * DM, DFF, DM, (bf16_t*)(wb + W_D1), 0, 0, scr, r, lane); continue; } r -= I_D;
        if (r < I_IN) { transpose_item(P.in[5] + (size_t)l * DM * NINS, DM, NINS, (bf16_t*)(wb + W_IN), 2, 0, scr, r, lane); continue; } r -= I_IN;
        if (r < I_W1) { transpose_item(P.in[8] + (size_t)l * 2048 * 256, 1024, 256, (bf16_t*)(wb + W_1K), 0, 0, scr, r, lane); continue; } r -= I_W1;
        if (r < I_W1) { transpose_item(P.in[8] + (size_t)l * 2048 * 256 + 1024 * 256, 1024, 256, (bf16_t*)(wb + W_1K), 0, 256, scr, r, lane); continue; } r -= I_W1;
        if (r < I_W1) { transpose_item(P.in[10] + (size_t)l * 2048 * 256, 1024, 256, (bf16_t*)(wb + W_1V), 0, 0, scr, r, lane); continue; } r -= I_W1;
        transpose_item(P.in[10] + (size_t)l * 2048 * 256 + 1024 * 256, 1024, 256, (bf16_t*)(wb + W_1V), 0, 256, scr, r, lane);
    }
}
DI void convert_late(const Params& P, int l, lds_u8* L, int gw, int ngw, int wave, int lane) {
    LAS float* scr = (LAS float*)(L + wave * 16640);
    unsigned char* ws = P.ws;
    constexpr int I_GU = 16 * 88, I_D = 44 * 16, I_P = 8 * 16, I_WO = 16 * 16;
    constexpr int NITEMS = I_GU + I_D + 2 * I_P + I_WO;
    for (int it = gw; it < NITEMS; it += ngw) {
        int r = it;
        if (r < I_GU) { transpose_item(P.in[19] + (size_t)l * DM * NGU, DM, NGU, (bf16_t*)(ws + W_GU2), 1, 0, scr, r, lane); continue; } r -= I_GU;
        if (r < I_D) { transpose_item(P.in[20] + (size_t)l * DFF * DM, DFF, DM, (bf16_t*)(ws + W_D2), 0, 0, scr, r, lane); continue; } r -= I_D;
        if (r < I_P) { transpose_item(P.in[15] + (size_t)l * 512 * DM, 512, DM, (bf16_t*)(ws + W_PA), 0, 0, scr, r, lane); continue; } r -= I_P;
        if (r < I_P) { transpose_item(P.in[16] + (size_t)l * 512 * DM, 512, DM, (bf16_t*)(ws + W_PB), 0, 0, scr, r, lane); continue; } r -= I_P;
        transpose_item(P.in[17] + (size_t)l * DM * DM, DM, DM, (bf16_t*)(ws + W_WO), 0, 0, scr, r, lane);
    }
}

DI void prologue_phase(const Params& P, lds_u8* L, int gw, int ngw, int tid, int lane) {
    unsigned char* ws = P.ws;
    const float* x = P.in[0]; const float* gn = P.in[1];
    bf16_t* XG = (bf16_t*)(ws + WS_XG); float* ssq = (float*)(ws + WS_SSQ);
    f32x4 g4[4];
#pragma unroll
    for (int j = 0; j < 4; ++j) g4[j] = *((const f32x4*)gn + lane + 64 * j);
    for (int row = gw; row < MT; row += ngw) {
        const f32x4* xr = (const f32x4*)(x + (size_t)row * DM) + lane; f32x4* orow = (f32x4*)(P.out + (size_t)row * DM) + lane;
        u32x2* xg = (u32x2*)(XG + (size_t)row * DM) + lane;
        float s = 0.f;
#pragma unroll
        for (int j = 0; j < 4; ++j) { const f32x4 v = __builtin_nontemporal_load(xr + 64 * j); s += (v.x * v.x + v.y * v.y) + (v.z * v.z + v.w * v.w); __builtin_nontemporal_store(v, orow + 64 * j);
            const f32x4 w = v * g4[j]; u32x2 o; o.x = pk2(w.x, w.y); o.y = pk2(w.z, w.w); xg[64 * j] = o; }
        s = wave_sum(s);
        if (lane < 16) ssq[(size_t)row * 16 + lane] = (lane == 0) ? s : 0.f;
    }
    float* cs = (float*)(ws + WS_CS); float* sn = (float*)(ws + WS_SN);
    const int gtid = blockIdx.x * 512 + tid, ngt = gridDim.x * 512;
    for (int i = gtid; i < SEQ * 32; i += ngt) {
        const int pos = i >> 5, k = i & 31;
        const float inv = __builtin_amdgcn_exp2f(-(float)k * (13.287712379549449f / 32.0f));
        const float ang = (float)pos * inv;
        const double rev = (double)ang * 0.15915494309189535; const float fr = (float)(rev - floor(rev));
        cs[i] = __builtin_amdgcn_cosf(fr); sn[i] = __builtin_amdgcn_sinf(fr);
    }
}

DI void bias_phase(const Params& P, int l, lds_u8* L, int tid, int rank) {
    if (rank >= 0 && rank < 16) {
        const int kv = rank >> 3, cgp = rank & 7;
        const float* pe = P.in[kv ? 7 : 6] + (size_t)l * 2048; const float* w1 = P.in[kv ? 10 : 8] + (size_t)l * 2048 * 256;
        const int c = cgp * 32 + (tid & 31), ksl = tid >> 5; float a = 0.f;
#pragma unroll 8
        for (int k = ksl * 128; k < ksl * 128 + 128; ++k) a += pe[k] * w1[(size_t)k * 256 + c];
        LAS float* red = (LAS float*)L;
        __syncthreads();
        red[tid] = a; __syncthreads();
        if (tid < 32) { float s = 0.f;
#pragma unroll
            for (int i = 0; i < 16; ++i) s += red[i * 32 + tid];
            ((float*)(P.ws + WS_BIAS))[(l * 2 + kv) * 256 + cgp * 32 + tid] = s; }
        __syncthreads();
    }
}

#define MFMA32(a, b, c) __builtin_amdgcn_mfma_f32_32x32x16_bf16((a), (b), (c), 0, 0, 0)
DI f32x16 zero16() { f32x16 z; for (int i = 0; i < 16; ++i) z[i] = 0.f; return z; }

DI void sgu_phase(const Params& P, int l, lds_u8* L, int tid, int wave, int lane, int rank, int nrank) {
    unsigned char* ws = P.ws;
    const float* wsg = P.in[13] + (size_t)l * 8 * 128 * 128 + (size_t)wave * 128 * 128; const float* bs = P.in[14] + (size_t)l * 8 * 128 + wave * 128;
    const bf16_t* VPT = (const bf16_t*)(ws + WS_VPT); const bf16_t* U = (const bf16_t*)(ws + WS_U); bf16_t* YB = (bf16_t*)(ws + WS_YB);
    const float* ssqv = (const float*)(ws + WS_SSQV);
    LAS float* rsv = (LAS float*)L;
    const int rho = lane & 31, hh = lane >> 5;
    if (rank >= 0) for (int c = rank; c < MT / 128; c += nrank) {
        __syncthreads();
        if (tid < 128) { const float* p = ssqv + (size_t)(c * 128 + tid) * 8; float s = 0.f;
#pragma unroll
            for (int i = 0; i < 8; ++i) s += p[i];
            rsv[tid] = rsqrtf(s * (1.0f / 512.0f) + EPS); }
        __syncthreads();
        const bf16_t* vb = VPT + ((size_t)c * 512 + wave * 64) * 128;
#pragma unroll
        for (int tt = 0; tt < 4; ++tt) {
            f32x16 a0 = zero16(), a1 = zero16();
            const int t = 32 * tt + rho;
            const float* wrow = wsg + (size_t)t * 128;
            const int nks = 2 * (tt + 1);
#pragma unroll
            for (int ks = 0; ks < nks; ++ks) {
                const int s0 = 16 * ks + 8 * hh;
                const f32x4 w0 = *(const f32x4*)(wrow + s0), w1 = *(const f32x4*)(wrow + s0 + 4);
                float wv[8] = {w0.x, w0.y, w0.z, w0.w, w1.x, w1.y, w1.z, w1.w};
#pragma unroll
                for (int j = 0; j < 8; ++j) wv[j] = (s0 + j <= t) ? wv[j] * rsv[s0 + j] : 0.f;
                u32x4 bw; bw.x = pk2(wv[0], wv[1]); bw.y = pk2(wv[2], wv[3]); bw.z = pk2(wv[4], wv[5]); bw.w = pk2(wv[6], wv[7]);
                const bf16x8 bfrag = __builtin_bit_cast(bf16x8, bw);
                const bf16x8 af0 = *(const bf16x8*)(vb + (size_t)rho * 128 + s0), af1 = *(const bf16x8*)(vb + (size_t)(32 + rho) * 128 + s0);
                a0 = MFMA32(af0, bfrag, a0); a1 = MFMA32(af1, bfrag, a1);
            }
            const float bias = bs[t]; const size_t tok = (size_t)c * 128 + t;
#pragma unroll
            for (int dt = 0; dt < 2; ++dt)
#pragma unroll
                for (int q4 = 0; q4 < 4; ++q4) {
                    const int d = wave * 64 + 32 * dt + 8 * q4 + 4 * hh;
                    const u32x2 uu = *(const u32x2*)(U + tok * 512 + d);
                    const f32x16& a = dt ? a1 : a0;
                    u32x2 o; o.x = pk2(bflo(uu.x) * (a[4 * q4 + 0] + bias), bfhi(uu.x) * (a[4 * q4 + 1] + bias)); o.y = pk2(bflo(uu.y) * (a[4 * q4 + 2] + bias), bfhi(uu.y) * (a[4 * q4 + 3] + bias));
                    *(u32x2*)(YB + tok * 512 + d) = o;
                }
        }
    }
}

DI void cmp2_phase(const Params& P, int l, lds_u8* L, int tid, int wave, int lane) {
    unsigned char* ws = P.ws;
    LAS float* hid = (LAS float*)L;
    const float* cs = (const float*)(ws + WS_CS); const float* sn = (const float*)(ws + WS_SN);
    for (int u = blockIdx.x; u < 512; u += gridDim.x) {
        const int kv = u >> 8, bg = (u >> 5) & 7, ng = u & 31;
        const float* Y = (const float*)(ws + (kv ? WS_YV : WS_YK)); const float* bias = (const float*)(ws + WS_BIAS) + (l * 2 + kv) * 256;
        const float* w2 = P.in[kv ? 11 : 9] + (size_t)l * 256 * 64;
        __syncthreads();
        { LAS f32x4* w2l4 = (LAS f32x4*)(L + 16384); const f32x4* w2g = (const f32x4*)w2;
#pragma unroll
          for (int i = 0; i < 8; ++i) w2l4[tid + 512 * i] = w2g[tid + 512 * i]; }
#pragma unroll
        for (int i = 0; i < 8; ++i) {
            const int idx = tid + 512 * i, r = idx >> 8, c = idx & 255, n = 16 * ng + r; const size_t jrow = (size_t)bg * 512 + n;
            float v = Y[jrow * 512 + c] + bias[c]; if (n < 511) v += Y[(jrow + 1) * 512 + 256 + c];
            hid[r * 256 + c] = gelu_tanh(v);
        }
        __syncthreads();
        float a0 = 0.f, a1 = 0.f; const LAS float* h0 = hid + (2 * wave) * 256; const LAS float* h1 = h0 + 256;
        const LAS float* w2l = (const LAS float*)(L + 16384) + lane;
#pragma unroll 16
        for (int k = 0; k < 256; ++k) { const float w = w2l[k * 64]; a0 += h0[k] * w; a1 += h1[k] * w; }
#pragma unroll
        for (int rr = 0; rr < 2; ++rr) {
            const int n = 16 * ng + 2 * wave + rr; float a = rr ? a1 : a0;
            if (kv == 0) {
                const float pr = __shfl_xor(a, 32); const int pos = 16 * n + 31; float o = 0.f;
                if (n < 511) { const float c = cs[pos * 32 + (lane & 31)], s = sn[pos * 32 + (lane & 31)]; o = (lane < 32) ? a * c - pr * s : a * c + pr * s; }
                ((bf16_t*)(ws + WS_KCMP))[((size_t)bg * 512 + n) * 64 + lane] = f2bf(o);
            } else {
                if (n >= 511) a = 0.f;
                ((bf16_t*)(ws + WS_VCMPT))[(((size_t)bg * 8 + (n >> 6)) * 64 + lane) * 64 + (n & 63)] = f2bf(a);
            }
        }
    }
}

constexpr int A_KB = 0, A_VB = 32768, A_IMP = 65536, IMPW = 132, A_SELM = A_IMP + 64 * IMPW * 4;
constexpr int A_QF = A_SELM + 1024;
static_assert(A_QF + 32768 <= XB_ST_OFF, "attention LDS map");
constexpr size_t WS_OF = WS_YK;

DI void attn_load(const bf16_t* kt, const bf16_t* vt, int wave, int lane, u32x4& kr, u32x4& vr) {
    kr = *(const u32x4*)(kt + lane * 64 + wave * 8); vr = *(const u32x4*)(vt + lane * 64 + wave * 8);
}
DI void attn_store(lds_u8* L, int ofs, int wave, int lane, const u32x4& kr, const u32x4& vr) {
    const int slot = (lane & ~12) | ((lane & 4) << 1) | ((lane & 8) >> 1);
    *(LAS u32x4*)(L + A_KB + ofs + wave * 1024 + slot * 16) = kr;
    *(LAS u32x4*)(L + A_VB + ofs + wave * 1024 + lane * 16) = vr;
}
DI f32x16 splat16(float v) { f32x16 z; for (int i = 0; i < 16; ++i) z[i] = v; return z; }
DI void qk_tile(lds_u8* L, int ofs, const lds_u8* qfl, int rho, int hh, float cinit, f32x16& s0, f32x16& s1) {
    const f32x16 cv = splat16(cinit);
#pragma unroll
    for (int c = 0; c < 4; ++c) {
        const lds_u8* kb = L + A_KB + ofs + (2 * c + hh) * 1024 + rho * 16;
        const bf16x8 k0 = *(const LAS bf16x8*)kb, k1 = *(const LAS bf16x8*)(kb + 512), q = *(const LAS bf16x8*)(qfl + c * 1024);
        if (c == 0) { s0 = MFMA32(k0, q, cv); s1 = MFMA32(k1, q, cv); } else { s0 = MFMA32(k0, q, s0); s1 = MFMA32(k1, q, s1); }
    }
}
DI void qk_tile_r(lds_u8* L, int ofs, const bf16x8 (&qr)[4], int rho, int hh, float cinit, f32x16& s0, f32x16& s1) {
    const f32x16 cv = splat16(cinit);
#pragma unroll
    for (int c = 0; c < 4; ++c) {
        const lds_u8* kb = L + A_KB + ofs + (2 * c + hh) * 1024 + rho * 16;
        const bf16x8 k0 = *(const LAS bf16x8*)kb, k1 = *(const LAS bf16x8*)(kb + 512);
        if (c == 0) { s0 = MFMA32(k0, qr[0], cv); s1 = MFMA32(k1, qr[0], cv); } else { s0 = MFMA32(k0, qr[c], s0); s1 = MFMA32(k1, qr[c], s1); }
    }
}
DI void mask_range(f32x16& s0, f32x16& s1, int hh, int lo, int hi) {
#pragma unroll
    for (int i = 0; i < 16; ++i) { const int k = 16 * (i >> 3) + 8 * hh + (i & 7);
        if (k < lo || k > hi) s0[i] = -INFINITY; if (k + 32 < lo || k + 32 > hi) s1[i] = -INFINITY; }
}
DI float xhalf_max(float a) {
    const unsigned u = __float_as_uint(a);
    auto rr = __builtin_amdgcn_permlane32_swap(u, u, false, false);
    return fmaxf(__uint_as_float(rr[0]), __uint_as_float(rr[1]));
}
DI float tile_max_lane(const f32x16& s0, const f32x16& s1) {
    float a = fmaxf(fmaxf(s0[0], s1[0]), s0[1]), b = fmaxf(fmaxf(s1[1], s0[2]), s1[2]);
#pragma unroll
    for (int i = 3; i < 15; i += 2) { a = fmaxf(fmaxf(a, s0[i]), s1[i]); b = fmaxf(fmaxf(b, s0[i + 1]), s1[i + 1]); }
    a = fmaxf(fmaxf(a, s0[15]), s1[15]); return fmaxf(a, b);
}
DI void pv_tile(lds_u8* L, int ofs, const f32x16& p0, const f32x16& p1, int rho, int hh, f32x16& o0, f32x16& o1) {
#pragma unroll
    for (int sub = 0; sub < 2; ++sub)
#pragma unroll
        for (int s = 0; s < 2; ++s) {
            const f32x16& p = sub ? p1 : p0;
            u32x4 w; w.x = pk2(p[8 * s + 0], p[8 * s + 1]); w.y = pk2(p[8 * s + 2], p[8 * s + 3]); w.z = pk2(p[8 * s + 4], p[8 * s + 5]); w.w = pk2(p[8 * s + 6], p[8 * s + 7]);
            const bf16x8 pf = __builtin_bit_cast(bf16x8, w);
            const lds_u8* vb = L + A_VB + ofs + (2 * (2 * sub + s) + hh) * 1024 + rho * 16;
            const bf16x8 v0 = *(const LAS bf16x8*)vb, v1 = *(const LAS bf16x8*)(vb + 512);
            o0 = MFMA32(v0, pf, o0); o1 = MFMA32(v1, pf, o1);
        }
}

template <int MODE>
DI void tile_range(int tt, int t_hi, int qb, int ql, int nmax, u64 sel_lo, u64 sel_hi, int& lo, int& hi) {
    lo = 0; hi = 63;
    const int tq = (tt <= t_hi) ? tt : 0;
    if (MODE <= 1) hi = nmax - 64 * tq;
    if (MODE == 2) { const u64 wsel = (tq < 64) ? (sel_lo >> tq) : (sel_hi >> (tq - 64)); hi = (wsel & 1ull) ? ((tq == qb) ? ql : 63) : -1; }
    if (MODE == 3) { if (tq == qb) hi = ql; if (tq == qb - 8) lo = ql + 1; }
    if (hi > 63) hi = 63;
    if (tt > t_hi) hi = -1;
}
DI float quad_xor1(float v) { return __int_as_float(__builtin_amdgcn_update_dpp(0, __float_as_int(v), 0xB1, 0xF, 0xF, true)); }
DI float quad_xor2(float v) { return __int_as_float(__builtin_amdgcn_update_dpp(0, __float_as_int(v), 0x4E, 0xF, 0xF, true)); }
DI void imp_accum(const f32x16& s0, const f32x16& s1, int tt, int rho, int hh, LAS float* improw, float& carry) {
    float a[4], b[4], x[4];
#pragma unroll
    for (int r = 0; r < 4; ++r) {
        const f32x16& p = (r >> 1) ? s1 : s0; const int o = 8 * (r & 1);
        a[r] = p[o + 0] + p[o + 1] + p[o + 2] + 0.5f * p[o + 3];
        b[r] = 0.5f * p[o + 3] + p[o + 4] + p[o + 5] + p[o + 6] + 0.5f * p[o + 7];
        x[r] = __shfl_xor(0.5f * p[o + 7], 32);
    }
    float E[4];
    E[0] = a[0] + (hh ? x[0] : carry);
#pragma unroll
    for (int r = 1; r < 4; ++r) E[r] = a[r] + (hh ? x[r] : x[r - 1]);
    carry = x[3];
#pragma unroll
    for (int r = 0; r < 4; ++r) { E[r] += quad_xor1(E[r]); E[r] += quad_xor2(E[r]); b[r] += quad_xor1(b[r]); b[r] += quad_xor2(b[r]); }
    if ((rho & 3) == 0) { LAS float* d = improw + 16 * tt + 2 * hh;
#pragma unroll
        for (int r = 0; r < 4; ++r) { d[4 * r] = E[r]; d[4 * r + 1] = b[r]; } }
}
template <int MODE>
DI void attn_run(lds_u8* L, const bf16_t* Kb, const bf16_t* Vb, int t_lo, int t_hi, const lds_u8* qf, int wave, int lane, int qb, int ql, int nmax,
                 u64 sel_lo, u64 sel_hi, float& m, float& l, int& started, f32x16& o0, f32x16& o1, float inv_l, LAS float* improw) {
    const int rho = lane & 31, hh = lane >> 5;
    const int npair = (t_hi - t_lo + 2) >> 1;
    float icarry = 0.f;
    u32x4 kr0, vr0, kr1, vr1;
    { const int tb0 = (t_lo + 1 <= t_hi) ? t_lo + 1 : t_lo;
      attn_load(Kb + (size_t)t_lo * 4096, Vb + (size_t)t_lo * 4096, wave, lane, kr0, vr0);
      attn_load(Kb + (size_t)tb0 * 4096, Vb + (size_t)tb0 * 4096, wave, lane, kr1, vr1); }
    attn_store(L, 0, wave, lane, kr0, vr0); attn_store(L, 8192, wave, lane, kr1, vr1);
    __syncthreads();
    int st = 0;
    for (int pi = 0; pi < npair; ++pi) {
        const int ta = t_lo + 2 * pi, tb = ta + 1;
        const bool more = pi + 1 < npair;
        if (more) { const int na = ta + 2, nb = (ta + 3 <= t_hi) ? ta + 3 : t_lo;
            attn_load(Kb + (size_t)na * 4096, Vb + (size_t)na * 4096, wave, lane, kr0, vr0);
            attn_load(Kb + (size_t)nb * 4096, Vb + (size_t)nb * 4096, wave, lane, kr1, vr1); }
        int loA, hiA, loB, hiB;
        tile_range<MODE>(ta, t_hi, qb, ql, nmax, sel_lo, sel_hi, loA, hiA);
        tile_range<MODE>(tb, t_hi, qb, ql, nmax, sel_lo, sel_hi, loB, hiB);
        const bool actA = (hiA >= loA) && (hiA >= 0), actB = (hiB >= loB) && (hiB >= 0);
        if (__ballot(actA || actB) == 0ull) icarry = 0.f;
        if (__ballot(actA || actB) != 0ull) {
            const int so = st * 16384;
            f32x16 a0, a1, b0, b1;
            qk_tile(L, so, qf, rho, hh, actA ? -m : -INFINITY, a0, a1);
            asm volatile("" ::: "memory");
            qk_tile(L, so + 8192, qf, rho, hh, actB ? -m : -INFINITY, b0, b1);
            asm volatile("" ::: "memory");
            if (__ballot(actA && (loA > 0 || hiA < 63)) != 0ull) mask_range(a0, a1, hh, loA, hiA);
            if (__ballot(actB && (loB > 0 || hiB < 63)) != 0ull) mask_range(b0, b1, hh, loB, hiB);
            if (MODE != 1) {
                float rm = fmaxf(tile_max_lane(a0, a1), tile_max_lane(b0, b1)); rm = xhalf_max(rm);
                float delta = 0.f; bool first = false;
                if (rm > -INFINITY) { if (!started) { delta = rm; first = true; started = 1; } else if (rm > 8.f) delta = rm; }
                if (__ballot(delta != 0.f) != 0ull) {
                    m += delta; const float f = first ? 1.0f : __builtin_amdgcn_exp2f(-delta); l *= f;
#pragma unroll
                    for (int i = 0; i < 16; ++i) { a0[i] -= delta; a1[i] -= delta; b0[i] -= delta; b1[i] -= delta; if (MODE >= 2) { o0[i] *= f; o1[i] *= f; } }
                }
                float sum = 0.f, sum2 = 0.f;
#pragma unroll
                for (int i = 0; i < 16; ++i) { a0[i] = __builtin_amdgcn_exp2f(a0[i]); a1[i] = __builtin_amdgcn_exp2f(a1[i]); sum += a0[i] + a1[i]; }
#pragma unroll
                for (int i = 0; i < 16; ++i) { b0[i] = __builtin_amdgcn_exp2f(b0[i]); b1[i] = __builtin_amdgcn_exp2f(b1[i]); sum2 += b0[i] + b1[i]; }
                l += sum + sum2;
                if (MODE >= 2) { pv_tile(L, so, a0, a1, rho, hh, o0, o1); asm volatile("" ::: "memory"); pv_tile(L, so + 8192, b0, b1, rho, hh, o0, o1); }
            } else {
#pragma unroll
                for (int i = 0; i < 16; ++i) { a0[i] = __builtin_amdgcn_exp2f(a0[i]) * inv_l; a1[i] = __builtin_amdgcn_exp2f(a1[i]) * inv_l;
                                               b0[i] = __builtin_amdgcn_exp2f(b0[i]) * inv_l; b1[i] = __builtin_amdgcn_exp2f(b1[i]) * inv_l; }
                pv_tile(L, so, a0, a1, rho, hh, o0, o1); asm volatile("" ::: "memory"); pv_tile(L, so + 8192, b0, b1, rho, hh, o0, o1);
                imp_accum(a0, a1, ta, rho, hh, improw, icarry);
                if (tb <= t_hi) imp_accum(b0, b1, tb, rho, hh, improw, icarry);
            }
        }
        if (more) { attn_store(L, (st ^ 1) * 16384, wave, lane, kr0, vr0); attn_store(L, (st ^ 1) * 16384 + 8192, wave, lane, kr1, vr1); }
        __syncthreads();
        st ^= 1;
    }
}

DI void pv_packed(lds_u8* L, int ofs, const u32x4 (&pw)[4], int rho, int hh, f32x16& o0, f32x16& o1) {
#pragma unroll
    for (int c16 = 0; c16 < 4; ++c16) {
        const bf16x8 pf = __builtin_bit_cast(bf16x8, pw[c16]);
        const lds_u8* vb = L + A_VB + ofs + (2 * c16 + hh) * 1024 + rho * 16;
        const bf16x8 v0 = *(const LAS bf16x8*)vb, v1 = *(const LAS bf16x8*)(vb + 512);
        o0 = MFMA32(v0, pf, o0); o1 = MFMA32(v1, pf, o1);
    }
}
template <int MODE>
DI void attn_stag(lds_u8* L, const bf16_t* Kb, const bf16_t* Vb, int t_lo, int t_hi, const lds_u8* qf, int wave, int lane, int qb, int ql,
                  u64 sel_lo, u64 sel_hi, float& m, float& l, int& started, f32x16& o0, f32x16& o1) {
    const int rho = lane & 31, hh = lane >> 5;
    const bool late = wave >= 4;
    bf16x8 qr[4];
#pragma unroll
    for (int c = 0; c < 4; ++c) qr[c] = *(const LAS bf16x8*)(qf + c * 1024);
    u32x4 kr, vr;
    attn_load(Kb + (size_t)t_lo * 4096, Vb + (size_t)t_lo * 4096, wave, lane, kr, vr);
    { const int slot = (lane & ~12) | ((lane & 4) << 1) | ((lane & 8) >> 1);
      *(LAS u32x4*)(L + A_KB + wave * 1024 + slot * 16) = kr; *(LAS u32x4*)(L + A_VB + wave * 1024 + lane * 16) = vr; }
    __syncthreads();
    u32x4 pw[4]; bool havep = false; int vprev = 0, ks = 0, vs = 0;
    for (int tt = t_lo; tt <= t_hi; ++tt) {
        const bool more = tt < t_hi;
        if (more) attn_load(Kb + (size_t)(tt + 1) * 4096, Vb + (size_t)(tt + 1) * 4096, wave, lane, kr, vr);
        int lo, hi; tile_range<MODE>(tt, t_hi, qb, ql, 0, sel_lo, sel_hi, lo, hi);
        const bool act = (hi >= lo) && (hi >= 0);
        if (late && havep) { pv_packed(L, vprev * 8192, pw, rho, hh, o0, o1); havep = false; }
        if (__ballot(act) != 0ull) {
            f32x16 s0, s1; qk_tile_r(L, ks * 8192, qr, rho, hh, act ? -m : -INFINITY, s0, s1);
            asm volatile("" ::: "memory");
            if (__ballot(act && (lo > 0 || hi < 63)) != 0ull) mask_range(s0, s1, hh, lo, hi);
            float rm = tile_max_lane(s0, s1); rm = xhalf_max(rm);
            float delta = 0.f; bool first = false;
            if (rm > -INFINITY) { if (!started) { delta = rm; first = true; started = 1; } else if (rm > 8.f) delta = rm; }
            if (__ballot(delta != 0.f) != 0ull) {
                m += delta; const float f = first ? 1.0f : __builtin_amdgcn_exp2f(-delta); l *= f;
#pragma unroll
                for (int i = 0; i < 16; ++i) { s0[i] -= delta; s1[i] -= delta; o0[i] *= f; o1[i] *= f; }
            }
            float sum = 0.f;
#pragma unroll
            for (int i = 0; i < 16; ++i) { s0[i] = __builtin_amdgcn_exp2f(s0[i]); s1[i] = __builtin_amdgcn_exp2f(s1[i]); sum += s0[i]; sum += s1[i]; }
            l += sum;
#pragma unroll
            for (int c16 = 0; c16 < 4; ++c16) { const f32x16& p = (c16 >> 1) ? s1 : s0; const int b8 = 8 * (c16 & 1);
                pw[c16].x = pk2(p[b8 + 0], p[b8 + 1]); pw[c16].y = pk2(p[b8 + 2], p[b8 + 3]); pw[c16].z = pk2(p[b8 + 4], p[b8 + 5]); pw[c16].w = pk2(p[b8 + 6], p[b8 + 7]); }
            if (!late) pv_packed(L, vs * 8192, pw, rho, hh, o0, o1); else { havep = true; vprev = vs; }
        }
        const int ks1 = ks ^ 1, vs1 = (vs == 2) ? 0 : vs + 1;
        if (more) { const int slot = (lane & ~12) | ((lane & 4) << 1) | ((lane & 8) >> 1);
            *(LAS u32x4*)(L + A_KB + ks1 * 8192 + wave * 1024 + slot * 16) = kr; *(LAS u32x4*)(L + A_VB + vs1 * 8192 + wave * 1024 + lane * 16) = vr; }
        __syncthreads();
        ks = ks1; vs = vs1;
    }
    if (late && havep) pv_packed(L, vprev * 8192, pw, rho, hh, o0, o1);
    __syncthreads();
}

DI void attn_phase(const Params& P, lds_u8* L, int tid, int wave, int lane) {
    unsigned char* ws = P.ws;
    const bf16_t* Q = (const bf16_t*)(ws + WS_Q); const float* GN = (const float*)(ws + WS_GN); bf16_t* YA = (bf16_t*)(ws + WS_YA);
    const int rho = lane & 31, hh = lane >> 5, hd = rho & 3;
    LAS float* improw = (LAS float*)(L + A_IMP) + (wave * 8 + (rho >> 2)) * IMPW;
    LAS float* impw = (LAS float*)(L + A_IMP) + wave * 8 * IMPW;
    LAS u64* selm = (LAS u64*)(L + A_SELM);
    f32x4* ofl = (f32x4*)(ws + WS_OF) + ((size_t)blockIdx.x * 512 + tid) * 8;
    for (int u = blockIdx.x; u < 1024; u += gridDim.x) {
        const int iq = u >> 8, v = u & 255, bg = v & 7, sI = v >> 3;
        const int qb = (iq == 0) ? sI : (iq == 1) ? 63 - sI : (iq == 2) ? 64 + sI : 127 - sI;
        const int b = bg >> 1, g = bg & 1;
        const int ql = 8 * wave + (rho >> 2), t = 64 * qb + ql; const size_t tok = (size_t)b * SEQ + t;
        lds_u8* qf = L + A_QF + wave * 4096 + lane * 16;
#pragma unroll
        for (int c = 0; c < 4; ++c) *(LAS bf16x8*)(qf + c * 1024) = *(const bf16x8*)(Q + tok * 512 + g * 256 + hd * 64 + 16 * c + 8 * hh);
        for (int i = lane; i < 8 * IMPW; i += 64) impw[i] = 0.f;
        const bf16_t* Kc = (const bf16_t*)(ws + WS_KCMP) + (size_t)bg * 512 * 64; const bf16_t* Vc = (const bf16_t*)(ws + WS_VCMPT) + (size_t)bg * 512 * 64;
        const bf16_t* Ks = (const bf16_t*)(ws + WS_KSEL) + (size_t)bg * SEQ * 64; const bf16_t* Vs = (const bf16_t*)(ws + WS_VSELT) + (size_t)bg * SEQ * 64;
        const bf16_t* Kw = (const bf16_t*)(ws + WS_KWIN) + (size_t)bg * SEQ * 64; const bf16_t* Vw = (const bf16_t*)(ws + WS_VWINT) + (size_t)bg * SEQ * 64;
        const int nmax = (t - 31) >> 4;
        const int tc_hi = (4 * qb + 2) >> 6;
        f32x16 of0, of1, o0, o1; float m, l; int started;
#ifdef DUP_CMP
        for (int rep_ = 0; rep_ < 2; ++rep_) {
        if (rep_) { asm volatile("" :: "v"(o0), "v"(o1)); for (int i = lane; i < 8 * IMPW; i += 64) impw[i] = 0.f; }
#endif
        m = 0.f; l = 0.f; started = 0; o0 = zero16(); o1 = zero16();
        attn_run<0>(L, Kc, Vc, 0, tc_hi, qf, wave, lane, qb, ql, nmax, 0ull, 0ull, m, l, started, o0, o1, 0.f, improw);
        l += __shfl_xor(l, 32);
        const float inv_l = (l > 0.f) ? 1.0f / l : 0.f;
        attn_run<1>(L, Kc, Vc, 0, tc_hi, qf, wave, lane, qb, ql, nmax, 0ull, 0ull, m, l, started, o0, o1, inv_l, improw);
#pragma unroll
        for (int i = 0; i < 4; ++i) { const float gc = GN[tok * 32 + (g * 4 + hd) * 3 + 0];
            ofl[i] = (f32x4){gc * o0[4 * i], gc * o0[4 * i + 1], gc * o0[4 * i + 2], gc * o0[4 * i + 3]}; ofl[4 + i] = (f32x4){gc * o1[4 * i], gc * o1[4 * i + 1], gc * o1[4 * i + 2], gc * o1[4 * i + 3]}; }
        if (qb > 15) {
            const bool cand0 = lane < qb, cand1 = lane + 64 < qb; const u64 ltm = (1ull << lane) - 1ull;
            for (int qi = 0; qi < 8; ++qi) {
                const LAS float* row = impw + qi * IMPW;
                const unsigned k0 = cand0 ? __float_as_uint(row[lane]) : 0u, k1 = cand1 ? __float_as_uint(row[lane + 64]) : 0u;
                unsigned prefix = 0u;
                for (int bit = 30; bit >= 0; --bit) {
                    const unsigned trial = prefix | (1u << bit);
                    const int cnt = __popcll(__ballot(cand0 && k0 >= trial)) + __popcll(__ballot(cand1 && k1 >= trial));
                    if (cnt >= 15) prefix = trial;
                }
                const u64 gt0 = __ballot(cand0 && k0 > prefix), gt1 = __ballot(cand1 && k1 > prefix);
                const u64 eq0 = __ballot(cand0 && k0 == prefix), eq1 = __ballot(cand1 && k1 == prefix);
                const int need = 15 - (__popcll(gt0) + __popcll(gt1));
                const int r0 = __popcll(eq0 & ltm), r1 = __popcll(eq0) + __popcll(eq1 & ltm);
                const bool s0 = (lane == qb) || (cand0 && (k0 > prefix || (k0 == prefix && r0 < need)));
                const bool s1 = (lane + 64 == qb) || (cand1 && (k1 > prefix || (k1 == prefix && r1 < need)));
                const u64 m0 = __ballot(s0), m1 = __ballot(s1);
                if (lane == 0) { selm[(wave * 8 + qi) * 2] = m0; selm[(wave * 8 + qi) * 2 + 1] = m1; }
            }
        } else {
            if (lane < 8) { selm[(wave * 8 + lane) * 2] = (1ull << (qb + 1)) - 1ull; selm[(wave * 8 + lane) * 2 + 1] = 0ull; }
        }
        const u64 sel_lo = selm[(wave * 8 + (rho >> 2)) * 2], sel_hi = selm[(wave * 8 + (rho >> 2)) * 2 + 1];
        m = 0.f; l = 0.f; started = 0; o0 = zero16(); o1 = zero16();
        attn_stag<2>(L, Ks, Vs, 0, qb, qf, wave, lane, qb, ql, sel_lo, sel_hi, m, l, started, o0, o1);
#ifdef DUP_SEL
        asm volatile("" :: "v"(o0), "v"(o1), "v"(l), "v"(m));
        m = 0.f; l = 0.f; started = 0; o0 = zero16(); o1 = zero16();
        attn_stag<2>(L, Ks, Vs, 0, qb, qf, wave, lane, qb, ql, sel_lo, sel_hi, m, l, started, o0, o1);
#endif
        l += __shfl_xor(l, 32);
        { const float f = GN[tok * 32 + (g * 4 + hd) * 3 + 1] / l;
#pragma unroll
          for (int i = 0; i < 4; ++i) { ofl[i] = ofl[i] + (f32x4){f * o0[4 * i], f * o0[4 * i + 1], f * o0[4 * i + 2], f * o0[4 * i + 3]}; ofl[4 + i] = ofl[4 + i] + (f32x4){f * o1[4 * i], f * o1[4 * i + 1], f * o1[4 * i + 2], f * o1[4 * i + 3]}; } }
        m = 0.f; l = 0.f; started = 0; o0 = zero16(); o1 = zero16();
        attn_stag<3>(L, Kw, Vw, (qb >= 8) ? qb - 8 : 0, qb, qf, wave, lane, qb, ql, 0ull, 0ull, m, l, started, o0, o1);
        l += __shfl_xor(l, 32);
        { const float f = GN[tok * 32 + (g * 4 + hd) * 3 + 2] / l;
#pragma unroll
          for (int i = 0; i < 4; ++i) { const f32x4 pa = ofl[i], pb = ofl[4 + i];
            of0[4 * i] = pa.x + f * o0[4 * i]; of0[4 * i + 1] = pa.y + f * o0[4 * i + 1]; of0[4 * i + 2] = pa.z + f * o0[4 * i + 2]; of0[4 * i + 3] = pa.w + f * o0[4 * i + 3];
            of1[4 * i] = pb.x + f * o1[4 * i]; of1[4 * i + 1] = pb.y + f * o1[4 * i + 1]; of1[4 * i + 2] = pb.z + f * o1[4 * i + 2]; of1[4 * i + 3] = pb.w + f * o1[4 * i + 3]; } }
        bf16_t* yo = YA + tok * 512 + (g * 4 + hd) * 64 + 4 * hh;
#pragma unroll
        for (int q4 = 0; q4 < 4; ++q4) {
            u32x2 a; a.x = pk2(of0[4 * q4 + 0], of0[4 * q4 + 1]); a.y = pk2(of0[4 * q4 + 2], of0[4 * q4 + 3]); *(u32x2*)(yo + 8 * q4) = a;
            u32x2 c; c.x = pk2(of1[4 * q4 + 0], of1[4 * q4 + 1]); c.y = pk2(of1[4 * q4 + 2], of1[4 * q4 + 3]); *(u32x2*)(yo + 32 + 8 * q4) = c;
        }
    }
}

DI void final_phase(const Params& P, int gw, int ngw, int lane) {
    const float* ssq = (const float*)(P.ws + WS_SSQ); const float* gn = P.in[21];
    f32x4 g4[4];
#pragma unroll
    for (int j = 0; j < 4; ++j) g4[j] = *((const f32x4*)gn + lane + 64 * j);
    for (int row = gw; row < MT; row += ngw) {
        float s = (lane < 16) ? ssq[(size_t)row * 16 + lane] : 0.f; s = wave_sum(s);
        const float r = rsqrtf(s * (1.0f / 1024.0f) + EPS);
        f32x4* xr = (f32x4*)(P.out + (size_t)row * DM) + lane;
#pragma unroll
        for (int j = 0; j < 4; ++j) { const f32x4 v = __builtin_nontemporal_load(xr + 64 * j); __builtin_nontemporal_store(v * g4[j] * r, xr + 64 * j); }
    }
}

#define GEMM(EPI, A_, B_, M_, N_, K_, CID, E_) do { pg8::Gemm g_{(const bf16_t*)(A_), (const bf16_t*)(B_), (M_), (N_), (K_)}; pg8::StaticOrder S_; S_.init((M_), (N_), G, (CID)); \
    pg8::gemm_phase<EPI, pg8::StaticOrder, true, true>(L, g_, S_, (E_)); } while (0)

DI const Params& getP() { auto p = __builtin_amdgcn_kernarg_segment_ptr(); asm volatile("" : "+s"(p)); return *(const Params*)p; }

__global__ void __launch_bounds__(512, 2) mega_fwd(Params Pk) {
    extern __shared__ __attribute__((aligned(16))) unsigned char lds_raw[];
    lds_u8* L = (lds_u8*)lds_raw;
#ifndef PM
#define PM 0xFFFF
#endif
#define PHASE_BEGIN const Params& P = getP(); unsigned char* ws = P.ws; (void)ws; int G = gridDim.x, bid = blockIdx.x; asm volatile("" : "+s"(G), "+s"(bid)); const int ngw = G * 8; (void)ngw; int l = lyr; asm volatile("" : "+s"(l)); (void)l; int tid = threadIdx.x; asm volatile("" : "+v"(tid)); \
    const int lane = tid & 63, wave = __builtin_amdgcn_readfirstlane(tid >> 6), gw = bid * 8 + wave; (void)lane; (void)gw;
#define XP_ float* X = P.out; bf16_t* XG = (bf16_t*)(ws + WS_XG); bf16_t* H = (bf16_t*)(ws + WS_H); float* ssq = (float*)(ws + WS_SSQ); \
    bf16_t* SGA = (bf16_t*)(ws + WS_SGA); bf16_t* SGB = (bf16_t*)(ws + WS_SGB); (void)X; (void)XG; (void)H; (void)ssq; (void)SGA; (void)SGB;

    { LAS unsigned* st0 = (LAS unsigned*)(L + XB_ST_OFF); if (threadIdx.x < 2) st0[threadIdx.x] = 0u; __syncthreads();
      (void)xcd_barrier_post((unsigned*)(getP().ws + WS_CTL), (volatile LAS unsigned*)st0); }
#define XSYNC_ONE() do { XcdBarrier xb_; xb_.bar = (unsigned*)(getP().ws + WS_CTL); xb_.x = xb_xcc_id(); xb_.st = (volatile LAS unsigned*)(L + XB_ST_OFF); xcd_barrier(xb_); } while (0)
#ifdef DUP_SYNC
#define GRID_SYNC() do { XSYNC_ONE(); XSYNC_ONE(); } while (0)
#else
#define GRID_SYNC() XSYNC_ONE()
#endif
    int lyr = 0;
    if (PM & 1) { PHASE_BEGIN prologue_phase(P, L, gw, ngw, tid, lane); }
#ifdef DUP_PRO
    { PHASE_BEGIN prologue_phase(P, L, gw, ngw, tid, lane); }
    { PHASE_BEGIN prologue_phase(P, L, gw, ngw, tid, lane); }
#endif
    __syncthreads();
    if (PM & 2) { PHASE_BEGIN convert_early(P, 0, L, gw, ngw, wave, lane); }
    cg::this_grid().sync();
#pragma nounroll
    for (lyr = 0; lyr < DEPTH; ++lyr) {
#define WB_ (ws + ((l & 1) ? W_ALT : 0))
        if (PM & 4) { PHASE_BEGIN XP_ EpiGateUp E{H, ssq}; GEMM(EpiGateUp, XG, WB_ + W_GU1, MT, NGU, DM, bid, E); }
#ifdef DUP_GU
        GRID_SYNC();
        { PHASE_BEGIN XP_ EpiGateUp E{H, ssq}; GEMM(EpiGateUp, XG, WB_ + W_GU1, MT, NGU, DM, bid, E); }
#endif
        GRID_SYNC();
        if (PM & 8) { PHASE_BEGIN XP_ EpiResid E{X, XG, P.in[4] + l * DM, ssq, 0.5f}; GEMM(EpiResid, H, WB_ + W_D1, MT, DM, DFF, bid, E); }
        GRID_SYNC();
        if (PM & 16) { PHASE_BEGIN XP_ EpiWin E{ws, P.in[12] + l * 512};
          GEMM(EpiWin, XG, WB_ + W_IN, MT, NINP, DM, bid, E); }
#ifdef DUP_WIN
        GRID_SYNC();
        { PHASE_BEGIN XP_ EpiWin E{ws, P.in[12] + l * 512};
          GEMM(EpiWin, XG, WB_ + W_IN, MT, NINP, DM, bid, E); }
#endif
        GRID_SYNC();
        if (PM & 32) { PHASE_BEGIN EpiF32 E{(float*)(ws + WS_YK), 512}; GEMM(EpiF32, ws + WS_KC, WB_ + W_1K, 4096, 512, 1024, bid, E); }
        if (PM & 32) { PHASE_BEGIN EpiF32 E{(float*)(ws + WS_YV), 512}; GEMM(EpiF32, ws + WS_VC, WB_ + W_1V, 4096, 512, 1024, (bid + G / 2) % G, E); }
#define P4RANK const int rank = bid, nrank = G; (void)nrank;
        if (PM & 64) { PHASE_BEGIN bias_phase(P, l, L, tid, (G >= 64) ? bid - 32 : bid); }
        if (PM & 64) { PHASE_BEGIN P4RANK sgu_phase(P, l, L, tid, wave, lane, rank, nrank); }
        __syncthreads();
        if (PM & 2) { PHASE_BEGIN P4RANK if (rank >= 0) convert_late(P, l, L, rank * 8 + wave, nrank * 8, wave, lane); }
#ifdef DUP_CONV
        { PHASE_BEGIN convert_late(P, l, L, gw, ngw, wave, lane); }
#endif
        GRID_SYNC();
        if (PM & 128) { PHASE_BEGIN cmp2_phase(P, l, L, tid, wave, lane); }
        __syncthreads();
        if (PM & 2) { PHASE_BEGIN if (l + 1 < DEPTH) convert_early(P, l + 1, L, gw, ngw, wave, lane); }
#ifdef DUP_CONV
        { PHASE_BEGIN if (l + 1 < DEPTH) convert_early(P, l + 1, L, gw, ngw, wave, lane); }
#endif
        GRID_SYNC();
        if (PM & 256) { PHASE_BEGIN attn_phase(P, L, tid, wave, lane); }
#ifdef DUP_ATT
        GRID_SYNC();
        { PHASE_BEGIN attn_phase(P, L, tid, wave, lane); }
#endif
        GRID_SYNC();
        if (PM & 512) { PHASE_BEGIN XP_ EpiProj E{SGA, SGB, 0}; GEMM(EpiProj, ws + WS_YA, ws + W_PA, MT, DM, 512, bid, E); }
        if (PM & 512) { PHASE_BEGIN XP_ EpiProj E{SGA, SGB, 1}; GEMM(EpiProj, ws + WS_YB, ws + W_PB, MT, DM, 512, bid, E); }
        GRID_SYNC();
        if (PM & 1024) { PHASE_BEGIN XP_ EpiResid E{X, XG, P.in[18] + l * DM, ssq, 1.0f}; GEMM(EpiResid, SGB, ws + W_WO, MT, DM, DM, bid, E); }
        GRID_SYNC();
        if (PM & 2048) { PHASE_BEGIN XP_ EpiGateUp E{H, ssq}; GEMM(EpiGateUp, XG, ws + W_GU2, MT, NGU, DM, bid, E); }
        GRID_SYNC();
        if (PM & 4096) { PHASE_BEGIN XP_ EpiResid E{X, XG, P.in[1] + ((l + 1 < DEPTH) ? (l + 1) : l) * DM, ssq, 0.5f}; GEMM(EpiResid, H, ws + W_D2, MT, DM, DFF, bid, E); }
        GRID_SYNC();
    }
    if (PM & 8192) { PHASE_BEGIN final_phase(P, gw, ngw, lane); }
}

extern "C" void kernel_launch(void* const* d_in, const int* in_sizes, int n_in, void* d_out, int out_size, void* d_ws, size_t ws_size, hipStream_t stream) {
    static int grid = 0;
    if (grid == 0) {
        if (n_in != 22 || out_size != MT * DM || ws_size < WS_END) { fprintf(stderr, "kernel_launch: unexpected shapes (n_in %d, out %d, ws %zu)\n", n_in, out_size, ws_size); grid = -1; return; }
        int dev = 0, cus = 0, per_cu = 0;
        hipGetDevice(&dev); hipDeviceGetAttribute(&cus, hipDeviceAttributeMultiprocessorCount, dev);
        hipFuncSetAttribute((const void*)mega_fwd, hipFuncAttributeMaxDynamicSharedMemorySize, LDS_BYTES);
        hipOccupancyMaxActiveBlocksPerMultiprocessor(&per_cu, (const void*)mega_fwd, 512, LDS_BYTES);
        (void)hipGetLastError();
        if (per_cu < 1) per_cu = 1;
        grid = cus * per_cu;
        if (grid > 256) grid = 256;
    }
    if (grid < 0) return;
    if (hipMemsetAsync((char*)d_ws + WS_CTL, 0, 16384, stream) != hipSuccess) { fprintf(stderr, "kernel_launch: memset of barrier words failed\n"); return; }
    Params p{};
    for (int i = 0; i < 22; ++i) p.in[i] = (const float*)d_in[i];
    p.out = (float*)d_out; p.ws = (unsigned char*)d_ws;
    void* args[] = {&p};
    hipError_t e = hipLaunchCooperativeKernel((const void*)mega_fwd, dim3(grid), dim3(512), args, LDS_BYTES, stream);
    if (e != hipSuccess) fprintf(stderr, "cooperative launch failed: %s (grid %d)\n", hipGetErrorString(e), grid);
}
```

```cpp
#include <hip/hip_runtime.h>
#include <hip/hip_cooperative_groups.h>
#include <cstdio>
#include <cstdint>
namespace cg = cooperative_groups;
namespace pg8 {
#define PG8_LAS __attribute__((address_space(3)))
typedef unsigned short bf16_t;
typedef short bf16x8 __attribute__((ext_vector_type(8)));
typedef float f32x4 __attribute__((ext_vector_type(4)));
typedef unsigned u32x4 __attribute__((ext_vector_type(4)));
constexpr int BM = 256, BK = 64, HALF = 128, HTB = HALF * BK * 2  , STAGE_BYTES = 8 * HTB, NXCD = 8, WGM = 8;

__host__ __device__ __forceinline__ int lds_byte(int r, int c) { const int st = (r >> 4) * 2 + (c >> 5), rr = r & 15, cc = c & 31, ob = rr * 64 + cc * 2; return st * 1024 + (ob ^ (((ob >> 9) & 1) << 5)); }
__host__ __device__ __forceinline__ void stage_rc(int b, int& R, int& C) { const int st = b / 1024, sb = b % 1024, swz = sb ^ (((sb >> 9) & 1) << 5); R = (st >> 1) * 16 + swz / 64; C = (st & 1) * 32 + (swz % 64) / 2; }
__host__ __device__ __forceinline__ int perm32(int rho) { const int n = rho >> 4, i = rho & 15; return 8 * (i >> 2) + 4 * n + (i & 3); }

struct Unit { int pm, pn; };
struct Gemm { const bf16_t* A; const bf16_t* Bt; int M, N, K; };

struct StaticOrder {
    int nM, nN, nwg, G, c;
    __host__ __device__ void init(int M, int N, int G_, int c_) { nM = M / BM; nN = N / BM; nwg = nM * nN; G = G_; c = c_; }
    __host__ __device__ bool next(int i, Unit& u) const {
        const long L = (long)i * G + c; if (L >= nwg) return false;
        int wgid = (int)L; { const int q = nwg / NXCD, r = nwg % NXCD, xcd = wgid % NXCD, off = wgid / NXCD; wgid = (xcd < r ? xcd * (q + 1) : r * (q + 1) + (xcd - r) * q) + off; }
        const int nig = WGM * nN, gid = wgid / nig, fm = gid * WGM, gsz = (nM - fm) < WGM ? (nM - fm) : WGM;
        u.pm = fm + ((wgid % nig) % gsz); u.pn = (wgid % nig) / gsz; return true;
    }
    __device__ __forceinline__ void a_ready(const Unit&) const {}
    __device__ __forceinline__ void done(const Unit&) const {}
};
__device__ __forceinline__ unsigned cvt_pk_bf16(float lo, float hi) { unsigned r; asm volatile("v_cvt_pk_bf16_f32 %0, %1, %2" : "=v"(r) : "v"(lo), "v"(hi)); return r; }
typedef float f32x2 __attribute__((ext_vector_type(2)));
template <class Epi, class Sched, bool ALIGN_EPI = false, bool SP2 = false>
__device__ __forceinline__ void gemm_phase(PG8_LAS unsigned char* lds, const Gemm g, const Sched& S, const Epi& E) {
    int tid0_ = threadIdx.x; asm volatile("" : "+v"(tid0_));
    const int tid = tid0_, wid = __builtin_amdgcn_readfirstlane(tid >> 6), lane = tid & 63, wr = wid >> 2, wc = wid & 3, fr = lane & 15, fq = lane >> 4;
    const int K = g.K, nt = K / BK;
    unsigned voffA[2], voffB[2];
#pragma unroll
    for (int i = 0; i < 2; ++i) { int R, C; stage_rc(tid * 16 + i * 8192, R, C); const int Rb = Epi::PERM ? ((R & ~31) + perm32(R & 31)) : R;
        voffA[i] = (unsigned)(R * K + C) * 2u; voffB[i] = (unsigned)(Rb * K + C) * 2u; }
    const size_t kstep = (size_t)(BK * 2);
    const size_t hstep = (size_t)HALF * K * 2;
    const size_t tstep = 2 * hstep;
    const unsigned ldsw = (unsigned)wid * 1024u;
    const int aoff = lds_byte(wr * 64 + fr, fq * 8), boff = lds_byte(wc * 32 + fr, fq * 8);
#define PG8_SA(b, h) (((b) * 2 + (h)) * HTB)
#define PG8_SB(b, h) ((4 + (b) * 2 + (h)) * HTB)
#define PG8_STAGE(bufoff, gbase, voff) do { _Pragma("unroll") for (int _i = 0; _i < 2; ++_i) \
        __builtin_amdgcn_global_load_lds((const unsigned*)((const char*)(gbase) + (voff)[_i]), (PG8_LAS unsigned*)(lds + (bufoff) + ldsw + _i * 8192), 16, 0, 0); } while (0)
#define PG8_LDA(dst, b, h) do { _Pragma("unroll") for (int m = 0; m < 4; ++m) _Pragma("unroll") for (int k = 0; k < 2; ++k) dst[m][k] = *(const PG8_LAS bf16x8*)(lds + PG8_SA(b, h) + aoff + m * 2048 + k * 1024); } while (0)
#define PG8_LDB(dst, b, h) do { _Pragma("unroll") for (int n = 0; n < 2; ++n) _Pragma("unroll") for (int k = 0; k < 2; ++k) dst[n][k] = *(const PG8_LAS bf16x8*)(lds + PG8_SB(b, h) + boff + n * 2048 + k * 1024); } while (0)
#define PG8_MMA(ai, bj, At, Bt) do { __builtin_amdgcn_s_setprio(1); _Pragma("unroll") for (int m = 0; m < 4; ++m) _Pragma("unroll") for (int n = 0; n < 2; ++n) _Pragma("unroll") for (int k = 0; k < 2; ++k) \
        acc[ai][bj][m][n] = __builtin_amdgcn_mfma_f32_16x16x32_bf16(Bt[n][k], At[m][k], acc[ai][bj][m][n], 0, 0, 0); __builtin_amdgcn_s_setprio(0); } while (0)
#define PG8_WAIT_V(n) asm volatile("s_waitcnt vmcnt(" #n ")" ::: "memory")
#define PG8_WAIT_L(n) asm volatile("s_waitcnt lgkmcnt(" #n ")" ::: "memory")
#define PG8_BAR __builtin_amdgcn_s_barrier()
#define PG8_SCHED __builtin_amdgcn_sched_barrier(0)
    Unit cur, nxt; int ui = 0;
    if (!S.next(0, cur)) return;
    f32x4 acc[2][2][4][2];
#pragma unroll
    for (int a = 0; a < 2; ++a)
#pragma unroll
        for (int b = 0; b < 2; ++b)
#pragma unroll
            for (int m = 0; m < 4; ++m)
#pragma unroll
                for (int n = 0; n < 2; ++n) acc[a][b][m][n] = (f32x4){0.f, 0.f, 0.f, 0.f};
    bf16x8 At[4][2], B0[2][2], B1[2][2];
    const char* cA = (const char*)g.A + (size_t)cur.pm * tstep; const char* cB = (const char*)g.Bt + (size_t)cur.pn * tstep;
    S.a_ready(cur);
    if constexpr (SP2) {
        PG8_STAGE(PG8_SB(0, 0), cB, voffB); PG8_STAGE(PG8_SB(0, 1), cB + hstep, voffB); PG8_STAGE(PG8_SA(0, 0), cA, voffA); PG8_STAGE(PG8_SA(0, 1), cA + hstep, voffA);
        if (wr == 1) PG8_BAR;
        PG8_WAIT_V(2); PG8_BAR;
        PG8_STAGE(PG8_SB(1, 0), cB + kstep, voffB); PG8_STAGE(PG8_SA(1, 0), cA + kstep, voffA); PG8_STAGE(PG8_SB(1, 1), cB + hstep + kstep, voffB);
        PG8_WAIT_V(6); PG8_BAR;
    } else {
        PG8_STAGE(PG8_SB(0, 0), cB, voffB); PG8_STAGE(PG8_SA(0, 0), cA, voffA); PG8_STAGE(PG8_SB(0, 1), cB + hstep, voffB); PG8_STAGE(PG8_SA(0, 1), cA + hstep, voffA);
        if (wr == 1) PG8_BAR;
        PG8_WAIT_V(4); PG8_BAR;
        PG8_STAGE(PG8_SB(1, 0), cB + kstep, voffB); PG8_STAGE(PG8_SA(1, 0), cA + kstep, voffA); PG8_STAGE(PG8_SB(1, 1), cB + hstep + kstep, voffB);
        PG8_WAIT_V(6); PG8_BAR;
    }
    for (;;) {
        const bool has_next = S.next(ui + 1, nxt);
        const char* nA = has_next ? (const char*)g.A + (size_t)nxt.pm * tstep : cA; const char* nB = has_next ? (const char*)g.Bt + (size_t)nxt.pn * tstep : cB;
        for (int t = 0; t < nt; t += 2) {
            const bool last = (t == nt - 2);
            const char* a1 = cA + (size_t)(t + 1) * kstep;
            const char* a2 = last ? nA : cA + (size_t)(t + 2) * kstep; const char* b2 = last ? nB : cB + (size_t)(t + 2) * kstep;
            const char* a3 = a2 + kstep; const char* b3 = b2 + kstep;
            if (last && has_next) S.a_ready(nxt);
            if constexpr (SP2) {
            PG8_LDB(B0, 0, 0); PG8_LDB(B1, 0, 1); PG8_SCHED; PG8_LDA(At, 0, 0); PG8_STAGE(PG8_SA(1, 1), a1 + hstep, voffA);
            PG8_WAIT_V(8); PG8_WAIT_L(0); PG8_BAR; PG8_MMA(0, 0, At, B0); PG8_MMA(0, 1, At, B1); PG8_BAR; PG8_SCHED;
            PG8_LDA(At, 0, 1); PG8_STAGE(PG8_SB(0, 0), b2, voffB); PG8_STAGE(PG8_SB(0, 1), b2 + hstep, voffB); PG8_STAGE(PG8_SA(0, 0), a2, voffA);
            PG8_WAIT_V(8); PG8_WAIT_L(0); PG8_BAR; PG8_MMA(1, 0, At, B0); PG8_MMA(1, 1, At, B1); PG8_BAR; PG8_SCHED;
            PG8_LDB(B0, 1, 0); PG8_LDB(B1, 1, 1); PG8_SCHED; PG8_LDA(At, 1, 0); PG8_STAGE(PG8_SA(0, 1), a2 + hstep, voffA);
            PG8_WAIT_V(8); PG8_WAIT_L(0); PG8_BAR; PG8_MMA(0, 0, At, B0); PG8_MMA(0, 1, At, B1); PG8_BAR; PG8_SCHED;
            PG8_LDA(At, 1, 1); PG8_STAGE(PG8_SB(1, 0), b3, voffB); PG8_STAGE(PG8_SB(1, 1), b3 + hstep, voffB); PG8_STAGE(PG8_SA(1, 0), a3, voffA);
            PG8_WAIT_V(8); PG8_WAIT_L(0); PG8_BAR; PG8_MMA(1, 0, At, B0); PG8_MMA(1, 1, At, B1); PG8_BAR; PG8_SCHED;
            } else {
            PG8_LDB(B0, 0, 0); PG8_SCHED; PG8_LDA(At, 0, 0); PG8_STAGE(PG8_SA(1, 1), a1 + hstep, voffA);
            PG8_WAIT_L(8); PG8_BAR; PG8_WAIT_L(0); PG8_MMA(0, 0, At, B0); PG8_BAR; PG8_SCHED;
            PG8_LDB(B1, 0, 1); PG8_STAGE(PG8_SB(0, 0), b2, voffB);
            PG8_BAR; PG8_WAIT_L(0); PG8_MMA(0, 1, At, B1); PG8_BAR;
            PG8_LDA(At, 0, 1); PG8_STAGE(PG8_SA(0, 0), a2, voffA);
            PG8_BAR; PG8_WAIT_L(0); PG8_MMA(1, 0, At, B0); PG8_BAR; PG8_SCHED;
            PG8_STAGE(PG8_SB(0, 1), b2 + hstep, voffB);
            PG8_WAIT_V(6); PG8_BAR; PG8_MMA(1, 1, At, B1); PG8_BAR;
            PG8_LDB(B0, 1, 0); PG8_SCHED; PG8_LDA(At, 1, 0); PG8_STAGE(PG8_SA(0, 1), a2 + hstep, voffA);
            PG8_WAIT_L(8); PG8_BAR; PG8_WAIT_L(0); PG8_MMA(0, 0, At, B0); PG8_BAR; PG8_SCHED;
            PG8_LDB(B1, 1, 1); PG8_STAGE(PG8_SB(1, 0), b3, voffB);
            PG8_BAR; PG8_WAIT_L(0); PG8_MMA(0, 1, At, B1); PG8_BAR;
            PG8_LDA(At, 1, 1); PG8_STAGE(PG8_SA(1, 0), a3, voffA);
            PG8_BAR; PG8_WAIT_L(0); PG8_MMA(1, 0, At, B0); PG8_BAR; PG8_SCHED;
            PG8_STAGE(PG8_SB(1, 1), b3 + hstep, voffB);
            PG8_WAIT_V(6); PG8_BAR; PG8_MMA(1, 1, At, B1); PG8_BAR;
            }
        }
        if constexpr (ALIGN_EPI) { if (wr == 0) PG8_BAR; }
        if constexpr (!Epi::AFTER_DRAIN) { E(acc, cur, wr, wc, fr, fq); S.done(cur); }
        if (!has_next) break;
#pragma unroll
        for (int a = 0; a < 2; ++a)
#pragma unroll
            for (int b = 0; b < 2; ++b)
#pragma unroll
                for (int m = 0; m < 4; ++m)
#pragma unroll
                    for (int n = 0; n < 2; ++n) acc[a][b][m][n] = (f32x4){0.f, 0.f, 0.f, 0.f};
        cur = nxt; cA = nA; cB = nB; ++ui;
        if constexpr (ALIGN_EPI) { if (wr == 1) PG8_BAR; }
    }
    PG8_WAIT_V(0);
    if constexpr (!ALIGN_EPI) { if (wr == 0) PG8_BAR; }
    PG8_BAR;
    if constexpr (Epi::AFTER_DRAIN) { E.fused(acc, cur, wr, wc, fr, fq, lds, wid, lane); S.done(cur); }
#undef PG8_SA
#undef PG8_SB
#undef PG8_STAGE
#undef PG8_LDA
#undef PG8_LDB
#undef PG8_MMA
#undef PG8_WAIT_V
#undef PG8_WAIT_L
#undef PG8_BAR
#undef PG8_SCHED
}
}

#define DI __device__ __forceinline__
#define LAS __attribute__((address_space(3)))
typedef LAS unsigned char lds_u8;
typedef pg8::bf16_t bf16_t;
typedef pg8::bf16x8 bf16x8;
typedef pg8::f32x4 f32x4;
typedef pg8::u32x4 u32x4;
typedef float f32x16 __attribute__((ext_vector_type(16)));
typedef unsigned u32x2 __attribute__((ext_vector_type(2)));
typedef unsigned long long u64;

constexpr int NB = 4, SEQ = 8192, DM = 1024, MT = NB * SEQ, DFF = 2816, NGU = 5632, NINP = 4608, NINS = 4376, DEPTH = 4;
constexpr float EPS = 1e-6f;
constexpr float C2 = 0.125f * 1.4426950408889634f;
constexpr int LDS_BYTES = 143360, XB_ST_OFF = 143360 - 64;

constexpr size_t MiB = 1u << 20;
constexpr size_t W_GU1 = 0, W_D1 = 11 * MiB, W_IN = W_D1 + 11 * MiB / 2, W_1K = W_IN + 9 * MiB, W_1V = W_1K + 1 * MiB,
                 W_GU2 = W_1V + 1 * MiB, W_D2 = W_GU2 + 11 * MiB, W_PA = W_D2 + 11 * MiB / 2, W_PB = W_PA + 1 * MiB, W_WO = W_PB + 1 * MiB;
static_assert(W_WO + 2 * MiB == 48 * MiB, "weight map");
constexpr size_t WS_XG = 48 * MiB, WS_H = 112 * MiB;
constexpr size_t WS_Q = WS_H, WS_KSEL = WS_H + 32 * MiB, WS_KWIN = WS_H + 40 * MiB, WS_KC = WS_H + 48 * MiB, WS_VC = WS_H + 56 * MiB, WS_VSELT = WS_H + 64 * MiB,
                 WS_VWINT = WS_H + 72 * MiB, WS_U = WS_H + 80 * MiB, WS_VPT = WS_H + 112 * MiB, WS_YA = WS_H + 144 * MiB;
constexpr size_t WS_SGA = 288 * MiB, WS_SGB = 352 * MiB, WS_YB = 416 * MiB, WS_SSQ = 448 * MiB, WS_SSQV = 450 * MiB, WS_GN = 451 * MiB, WS_YK = 455 * MiB,
                 WS_YV = 463 * MiB, WS_KCMP = 471 * MiB, WS_VCMPT = 471 * MiB + 512 * 1024, WS_CS = 472 * MiB, WS_SN = 473 * MiB, WS_BIAS = 474 * MiB, W_ALT = 475 * MiB, WS_CTL = 503 * MiB, WS_END = 504 * MiB;

typedef float f32x2_t __attribute__((ext_vector_type(2)));
typedef __bf16 bf16x2_t __attribute__((ext_vector_type(2)));
DI unsigned pk2(float lo, float hi) { f32x2_t v = {lo, hi}; bf16x2_t b = __builtin_convertvector(v, bf16x2_t); return __builtin_bit_cast(unsigned, b); }
DI bf16_t f2bf(float v) { return (bf16_t)(pk2(v, 0.f) & 0xffffu); }
DI float bflo(unsigned w) { return __uint_as_float(w << 16); }
DI float bfhi(unsigned w) { return __uint_as_float(w & 0xffff0000u); }
DI float fexp(float x) { return __builtin_amdgcn_exp2f(x * 1.4426950408889634f); }
DI float sigmoidf_(float x) { return __builtin_amdgcn_rcpf(1.0f + fexp(-x)); }
DI float siluf_(float x) { return x * sigmoidf_(x); }
DI float gelu_tanh(float x) { const float u = 0.7978845608028654f * (x + 0.044715f * x * x * x); return x * sigmoidf_(2.0f * u); }
DI float wave_sum(float v) {
#pragma unroll
    for (int o = 1; o < 64; o <<= 1) v += __shfl_xor(v, o);
    return v;
}
#define XB_TMO      128
#define XB_XCNT(j)  (256  + 64 * (j))
#define XB_XSUB(j)  (1280 + 64 * (j))
#define XB_XGEN(j)  (2304 + 64 * (j))
#define XB_TOP      3328
#define XB_TOPGEN   3392
#define XCD_BAR_WORDS 3456
#define XB_SPIN_CAP (1u << 18)

__device__ __forceinline__ unsigned xb_ld(unsigned* p)              { return __hip_atomic_load(p, __ATOMIC_RELAXED, __HIP_MEMORY_SCOPE_AGENT); }
__device__ __forceinline__ unsigned xb_add(unsigned* p, unsigned v) { return __hip_atomic_fetch_add(p, v, __ATOMIC_RELAXED, __HIP_MEMORY_SCOPE_AGENT); }
__device__ __forceinline__ unsigned xb_xcc_id() { return (unsigned)__builtin_amdgcn_s_getreg((3 << 11) | 20) & 0xFu; }
#define XB_SPIN(cond, bar) do { unsigned _sp = 0; while (cond) { __builtin_amdgcn_s_sleep(1); \
    if ((++_sp & 255u) == 0u) { if (xb_ld(&(bar)[XB_TMO])) break; if (_sp > XB_SPIN_CAP) { atomicAdd(&(bar)[XB_TMO], 1u); break; } } } } while (0)

struct XcdBarrier {
    unsigned* bar; unsigned x;
    volatile LAS unsigned* st;
};

__device__ __forceinline__ XcdBarrier xcd_barrier_post(unsigned* bar, volatile LAS unsigned* st) {
    XcdBarrier b; b.bar = bar; b.x = xb_xcc_id(); b.st = st;
    if (threadIdx.x == 0) (void)xb_add(&bar[XB_XCNT(b.x)], 1u);
    return b;
}
__device__ __forceinline__ void xcd_barrier_complete(unsigned* bar, unsigned x, unsigned& nloc, unsigned& nx) {
    const unsigned G = gridDim.x * gridDim.y * gridDim.z;
    unsigned sum, cnt, mine, sp = 0u;
    for (;;) {
        sum = 0u; cnt = 0u; mine = 0u;
#pragma unroll
        for (unsigned j = 0; j < 16; ++j) { const unsigned c = xb_ld(&bar[XB_XCNT(j)]); sum += c; cnt += (c > 0u) ? 1u : 0u; mine = (j == x) ? c : mine; }
        if (sum == G) break;
        __builtin_amdgcn_s_sleep(1);
        if ((++sp & 255u) == 0u) { if (xb_ld(&bar[XB_TMO])) break; if (sp > XB_SPIN_CAP) { atomicAdd(&bar[XB_TMO], 1u); break; } }
    }
    nloc = mine > 0u ? mine : 1u; nx = cnt > 0u ? cnt : 1u;
}

__device__ __forceinline__ void xcd_barrier(const XcdBarrier& b) {
    asm volatile("s_waitcnt vmcnt(0)" ::: "memory");
    __syncthreads();
    if (threadIdx.x == 0) {
        unsigned* bar = b.bar;
        __builtin_amdgcn_s_waitcnt(0);
        unsigned nloc = b.st[0], nx = b.st[1];
        if (nloc == 0u) { xcd_barrier_complete(bar, b.x, nloc, nx); b.st[0] = nloc; b.st[1] = nx; }
        const unsigned old = xb_add(&bar[XB_XSUB(b.x)], 1u);
        const unsigned gen = old / nloc;
        if (old + 1u == (gen + 1u) * nloc) {
            __builtin_amdgcn_fence(__ATOMIC_RELEASE, "agent");
            asm volatile("s_waitcnt vmcnt(0)" ::: "memory");
            const unsigned og = xb_add(&bar[XB_TOP], 1u);
            const unsigned tg = og / nx;
            if (og + 1u == (tg + 1u) * nx) xb_add(&bar[XB_TOPGEN], 1u);
            else XB_SPIN(xb_ld(&bar[XB_TOPGEN]) == tg, bar);
            __builtin_amdgcn_fence(__ATOMIC_ACQUIRE, "agent");
            xb_add(&bar[XB_XGEN(b.x)], 1u);
            asm volatile("s_waitcnt vmcnt(0)" ::: "memory");
        } else {
            XB_SPIN(xb_ld(&bar[XB_XGEN(b.x)]) == gen, bar);
            __builtin_amdgcn_fence(__ATOMIC_ACQUIRE, "agent");
            asm volatile("s_waitcnt vmcnt(0)" ::: "memory");
        }
    }
    __syncthreads();
}

DI u32x4 pack8(const f32x4 a, const f32x4 b) { u32x4 w; w.x = pk2(a.x, a.y); w.y = pk2(a.z, a.w); w.z = pk2(b.x, b.y); w.w = pk2(b.z, b.w); return w; }

__host__ __device__ __forceinline__ int map_gateup(int n) { const int part = n / DFF, c = n % DFF; return 256 * (c >> 7) + 128 * part + (c & 127); }
__host__ __device__ __forceinline__ int map_rope(int tile, int hl, int d) { return tile * 256 + (d >> 5) * 128 + hl * 32 + (d & 31); }
__host__ __device__ __forceinline__ int map_win(int n) {
    if (n < 512) { const int hq = n >> 6; return map_rope(hq >> 2, hq & 3, n & 63); }
    if (n < 640) return 3 * 256 + (n - 512);
    if (n < 768) return 3 * 256 + 128 + (n - 640);
    if (n < 896) { const int c = n - 768; return map_rope(2, c >> 6, c & 63); }
    if (n < 1024) return 4 * 256 + (n - 896);
    if (n < 1152) { const int c = n - 1024; return map_rope(2, 2 + (c >> 6), c & 63); }
    if (n < 1280) return 4 * 256 + 128 + (n - 1152);
    if (n < 1304) return 17 * 256 + (n - 1280);
    if (n < 2328) return 5 * 256 + (n - 1304);
    if (n < 3352) return 9 * 256 + (n - 2328);
    return 13 * 256 + (n - 3352);
}

DI void row_scales8(const float* ssq, int rowb, int fq, float (&rs)[8]) {
    f32x4 p[8];
#pragma unroll
    for (int i = 0; i < 8; ++i) p[i] = *(const f32x4*)(ssq + (size_t)(rowb + (i >> 2) * 128 + (i & 3) * 16) * 16 + 4 * fq);
#pragma unroll
    for (int i = 0; i < 8; ++i) { float s = (p[i].x + p[i].y) + (p[i].z + p[i].w); s += __shfl_xor(s, 16); s += __shfl_xor(s, 32); rs[i] = rsqrtf(s * (1.0f / 1024.0f) + EPS); }
    asm volatile("" ::: "memory");
}
#define EPI_FENCE() asm volatile("" ::: "memory")

typedef const f32x4 (&AccRef)[2][2][4][2];

struct EpiGateUp {
    static constexpr bool PERM = true, AFTER_DRAIN = false;
    bf16_t* H; const float* ssq;
    DI void operator()(AccRef acc, const pg8::Unit& u, int wr, int wc, int fr, int fq) const {
        const int rowb = u.pm * 256 + wr * 64 + fr; float rs8[8]; row_scales8(ssq, rowb, fq, rs8);
#pragma unroll
        for (int ai = 0; ai < 2; ++ai)
#pragma unroll
            for (int m = 0; m < 4; ++m) {
                const int row = rowb + ai * 128 + m * 16; const float r = rs8[ai * 4 + m]; f32x4 h[2];
#pragma unroll
                for (int n = 0; n < 2; ++n) { const f32x4 g = acc[ai][0][m][n] * r, uu = acc[ai][1][m][n] * r;
                    h[n].x = siluf_(g.x) * uu.x; h[n].y = siluf_(g.y) * uu.y; h[n].z = siluf_(g.z) * uu.z; h[n].w = siluf_(g.w) * uu.w; }
                *(u32x4*)(H + (size_t)row * DFF + u.pn * 128 + wc * 32 + 8 * fq) = pack8(h[0], h[1]);
                EPI_FENCE();
            }
    }
};

struct EpiResid {
    static constexpr bool PERM = true, AFTER_DRAIN = false;
    float* X; bf16_t* XG; const float* gn; float* ssq; float scale;
    DI void operator()(AccRef acc, const pg8::Unit& u, int wr, int wc, int fr, int fq) const {
        const int rowb = u.pm * 256 + wr * 64 + fr, colb = u.pn * 256 + wc * 32 + 8 * fq;
        f32x4 gv[2][2];
#pragma unroll
        for (int bj = 0; bj < 2; ++bj)
#pragma unroll
            for (int n = 0; n < 2; ++n) gv[bj][n] = *(const f32x4*)(gn + colb + bj * 128 + 4 * n);
        f32x4 cur[2][2], nxt[2][2];
        { const float* xp = X + (size_t)rowb * DM + colb;
          cur[0][0] = __builtin_nontemporal_load((const f32x4*)xp); cur[0][1] = __builtin_nontemporal_load((const f32x4*)(xp + 4)); cur[1][0] = __builtin_nontemporal_load((const f32x4*)(xp + 128)); cur[1][1] = __builtin_nontemporal_load((const f32x4*)(xp + 132)); }
#pragma unroll
        for (int it = 0; it < 8; ++it) {
            const int row = rowb + (it >> 2) * 128 + (it & 3) * 16; float ss = 0.f;
            if (it < 7) { const float* xp = X + (size_t)(rowb + ((it + 1) >> 2) * 128 + ((it + 1) & 3) * 16) * DM + colb;
                nxt[0][0] = __builtin_nontemporal_load((const f32x4*)xp); nxt[0][1] = __builtin_nontemporal_load((const f32x4*)(xp + 4)); nxt[1][0] = __builtin_nontemporal_load((const f32x4*)(xp + 128)); nxt[1][1] = __builtin_nontemporal_load((const f32x4*)(xp + 132)); }
#pragma unroll
            for (int bj = 0; bj < 2; ++bj) {
                float* xp = X + (size_t)row * DM + colb + bj * 128;
                const f32x4 x0 = cur[bj][0] + acc[it >> 2][bj][it & 3][0] * scale, x1 = cur[bj][1] + acc[it >> 2][bj][it & 3][1] * scale;
                __builtin_nontemporal_store(x0, (f32x4*)xp); __builtin_nontemporal_store(x1, (f32x4*)(xp + 4));
                ss += (x0.x * x0.x + x0.y * x0.y) + (x0.z * x0.z + x0.w * x0.w) + (x1.x * x1.x + x1.y * x1.y) + (x1.z * x1.z + x1.w * x1.w);
                *(u32x4*)(XG + (size_t)row * DM + colb + bj * 128) = pack8(x0 * gv[bj][0], x1 * gv[bj][1]);
            }
            ss += __shfl_xor(ss, 16); ss += __shfl_xor(ss, 32);
            if (fq == 0) ssq[(size_t)row * 16 + u.pn * 4 + wc] = ss;
            EPI_FENCE();
            if (it < 7) { cur[0][0] = nxt[0][0]; cur[0][1] = nxt[0][1]; cur[1][0] = nxt[1][0]; cur[1][1] = nxt[1][1]; }
        }
    }
};

struct EpiProj {
    static constexpr bool PERM = true, AFTER_DRAIN = false;
    bf16_t* SGA; bf16_t* SGB; int second;
    DI void operator()(AccRef acc, const pg8::Unit& u, int wr, int wc, int fr, int fq) const {
        const int rowb = u.pm * 256 + wr * 64 + fr, colb = u.pn * 256 + wc * 32 + 8 * fq;
        u32x4 ga[2], gb[2], na[2], nb[2];
        { const size_t off = (size_t)rowb * DM + colb; ga[0] = *(const u32x4*)(SGA + off); ga[1] = *(const u32x4*)(SGA + off + 128);
          if (second) { gb[0] = *(const u32x4*)(SGB + off); gb[1] = *(const u32x4*)(SGB + off + 128); } }
#pragma unroll
        for (int it = 0; it < 8; ++it) {
            const int row = rowb + (it >> 2) * 128 + (it & 3) * 16;
            if (it < 7) { const size_t off = (size_t)(rowb + ((it + 1) >> 2) * 128 + ((it + 1) & 3) * 16) * DM + colb;
                na[0] = *(const u32x4*)(SGA + off); na[1] = *(const u32x4*)(SGA + off + 128);
                if (second) { nb[0] = *(const u32x4*)(SGB + off); nb[1] = *(const u32x4*)(SGB + off + 128); } }
#pragma unroll
            for (int bj = 0; bj < 2; ++bj) {
                const size_t off = (size_t)row * DM + colb + bj * 128;
                const f32x4 a0 = acc[it >> 2][bj][it & 3][0], a1 = acc[it >> 2][bj][it & 3][1];
                const u32x4 g = ga[bj];
                if (!second) {
                    f32x4 t0, t1; t0.x = bflo(g.x) * a0.x; t0.y = bfhi(g.x) * a0.y; t0.z = bflo(g.y) * a0.z; t0.w = bfhi(g.y) * a0.w;
                    t1.x = bflo(g.z) * a1.x; t1.y = bfhi(g.z) * a1.y; t1.z = bflo(g.w) * a1.z; t1.w = bfhi(g.w) * a1.w;
                    *(u32x4*)(SGA + off) = pack8(t0, t1);
                } else {
                    const u32x4 h = gb[bj];
                    f32x4 t0, t1; t0.x = bflo(g.x) + bflo(h.x) * a0.x; t0.y = bfhi(g.x) + bfhi(h.x) * a0.y; t0.z = bflo(g.y) + bflo(h.y) * a0.z; t0.w = bfhi(g.y) + bfhi(h.y) * a0.w;
                    t1.x = bflo(g.z) + bflo(h.z) * a1.x; t1.y = bfhi(g.z) + bfhi(h.z) * a1.y; t1.z = bflo(g.w) + bflo(h.w) * a1.z; t1.w = bfhi(g.w) + bfhi(h.w) * a1.w;
                    *(u32x4*)(SGB + off) = pack8(t0, t1);
                }
            }
            EPI_FENCE();
            if (it < 7) { ga[0] = na[0]; ga[1] = na[1]; if (second) { gb[0] = nb[0]; gb[1] = nb[1]; } }
        }
    }
};

struct EpiF32 {
    static constexpr bool PERM = true, AFTER_DRAIN = false;
    float* Y; int ldc;
    DI void operator()(AccRef acc, const pg8::Unit& u, int wr, int wc, int fr, int fq) const {
        const int rowb = u.pm * 256 + wr * 64 + fr, colb = u.pn * 256 + wc * 32 + 8 * fq;
#pragma unroll
        for (int ai = 0; ai < 2; ++ai)
#pragma unroll
            for (int m = 0; m < 4; ++m)
#pragma unroll
                for (int bj = 0; bj < 2; ++bj) {
                    float* yp = Y + (size_t)(rowb + ai * 128 + m * 16) * ldc + colb + bj * 128;
                    *(f32x4*)yp = acc[ai][bj][m][0]; *(f32x4*)(yp + 4) = acc[ai][bj][m][1];
                }
    }
};

struct EpiWin {
    static constexpr bool PERM = true, AFTER_DRAIN = false;
    unsigned char* ws; const float* sgn;
    DI void operator()(AccRef acc, const pg8::Unit& u, int wr, int wc, int fr, int fq) const {
        const float* ssq = (const float*)(ws + WS_SSQ); bf16_t* Q = (bf16_t*)(ws + WS_Q); bf16_t* KSEL = (bf16_t*)(ws + WS_KSEL); bf16_t* KWIN = (bf16_t*)(ws + WS_KWIN);
        bf16_t* KC = (bf16_t*)(ws + WS_KC); bf16_t* VC = (bf16_t*)(ws + WS_VC); bf16_t* VSELT = (bf16_t*)(ws + WS_VSELT); bf16_t* VWINT = (bf16_t*)(ws + WS_VWINT);
        bf16_t* U = (bf16_t*)(ws + WS_U); bf16_t* VPT = (bf16_t*)(ws + WS_VPT); bf16_t* SGA = (bf16_t*)(ws + WS_SGA); bf16_t* SGB = (bf16_t*)(ws + WS_SGB);
        float* GN = (float*)(ws + WS_GN); float* ssqv = (float*)(ws + WS_SSQV); const float* cs = (const float*)(ws + WS_CS); const float* sn = (const float*)(ws + WS_SN);
        const int rowb = u.pm * 256 + wr * 64 + fr, pn = u.pn; float rs8[8]; row_scales8(ssq, rowb, fq, rs8);
        if (pn <= 2) {
#pragma unroll
            for (int ai = 0; ai < 2; ++ai)
#pragma unroll
                for (int m = 0; m < 4; ++m) {
                    const int row = rowb + ai * 128 + m * 16, pos = row & (SEQ - 1), bb = row >> 13; const float r = rs8[ai * 4 + m];
                    const float* cp = cs + pos * 32 + 8 * fq; const float* sp = sn + pos * 32 + 8 * fq;
                    f32x4 o1[2], o2[2];
#pragma unroll
                    for (int n = 0; n < 2; ++n) { const f32x4 c = *(const f32x4*)(cp + 4 * n), s = *(const f32x4*)(sp + 4 * n);
                        const f32x4 x1 = acc[ai][0][m][n] * r, x2 = acc[ai][1][m][n] * r; o1[n] = x1 * c - x2 * s; o2[n] = x2 * c + x1 * s;
                        if (pn < 2) { o1[n] = o1[n] * C2; o2[n] = o2[n] * C2; } }
                    bf16_t* dst;
                    if (pn < 2) dst = Q + (size_t)row * 512 + pn * 256 + wc * 64 + 8 * fq;
                    else dst = (wc < 2 ? KSEL : KWIN) + ((size_t)(bb * 2 + (wc & 1)) * SEQ + pos) * 64 + 8 * fq;
                    *(u32x4*)dst = pack8(o1[0], o1[1]); *(u32x4*)(dst + 32) = pack8(o2[0], o2[1]);
                }
        } else if (pn == 3) {
#pragma unroll
            for (int ai = 0; ai < 2; ++ai)
#pragma unroll
                for (int m = 0; m < 4; ++m) {
                    const int row = rowb + ai * 128 + m * 16, pos = row & (SEQ - 1), bb = row >> 13; const float r = rs8[ai * 4 + m];
#pragma unroll
                    for (int bj = 0; bj < 2; ++bj)
                        *(u32x4*)((bj ? VC : KC) + ((size_t)(bb * 2 + (wc >> 1)) * SEQ + pos) * 64 + (wc & 1) * 32 + 8 * fq) = pack8(acc[ai][bj][m][0] * r, acc[ai][bj][m][1] * r);
                }
        } else if (pn == 4) {
#pragma unroll
            for (int ai = 0; ai < 2; ++ai)
#pragma unroll
                for (int m = 0; m < 4; ++m) {
                    const int row = rowb + ai * 128 + m * 16, pos = row & (SEQ - 1), bb = row >> 13; const float r = rs8[ai * 4 + m];
#pragma unroll
                    for (int bj = 0; bj < 2; ++bj) {
                        bf16_t* base = (bj ? VWINT : VSELT) + (((size_t)(bb * 2 + (wc >> 1)) * 128 + (pos >> 6)) * 64 + (wc & 1) * 32 + 8 * fq) * 64 + (pos & 63);
#pragma unroll
                        for (int n = 0; n < 2; ++n) { const f32x4 v = acc[ai][bj][m][n] * r;
                            base[(4 * n + 0) * 64] = f2bf(v.x); base[(4 * n + 1) * 64] = f2bf(v.y); base[(4 * n + 2) * 64] = f2bf(v.z); base[(4 * n + 3) * 64] = f2bf(v.w); }
                    }
                }
        } else if (pn <= 6) {
#pragma unroll
            for (int ai = 0; ai < 2; ++ai)
#pragma unroll
                for (int m = 0; m < 4; ++m) {
                    const int row = rowb + ai * 128 + m * 16; const float r = rs8[ai * 4 + m];
#pragma unroll
                    for (int bj = 0; bj < 2; ++bj) { f32x4 g[2];
#pragma unroll
                        for (int n = 0; n < 2; ++n) { const f32x4 v = acc[ai][bj][m][n] * r; g[n].x = gelu_tanh(v.x); g[n].y = gelu_tanh(v.y); g[n].z = gelu_tanh(v.z); g[n].w = gelu_tanh(v.w); }
                        *(u32x4*)(U + (size_t)row * 512 + (pn - 5) * 256 + bj * 128 + wc * 32 + 8 * fq) = pack8(g[0], g[1]); }
                }
        } else if (pn <= 8) {
#pragma unroll
            for (int ai = 0; ai < 2; ++ai)
#pragma unroll
                for (int m = 0; m < 4; ++m) {
                    const int row = rowb + ai * 128 + m * 16; const float r = rs8[ai * 4 + m]; float ss = 0.f;
#pragma unroll
                    for (int bj = 0; bj < 2; ++bj) {
                        const int col0 = (pn - 7) * 256 + bj * 128 + wc * 32 + 8 * fq;
                        bf16_t* base = VPT + ((size_t)(row >> 7) * 512 + col0) * 128 + (row & 127);
#pragma unroll
                        for (int n = 0; n < 2; ++n) { const f32x4 v = acc[ai][bj][m][n] * r; const f32x4 gw = *(const f32x4*)(sgn + col0 + 4 * n);
                            const float g0 = gelu_tanh(v.x), g1 = gelu_tanh(v.y), g2 = gelu_tanh(v.z), g3 = gelu_tanh(v.w);
                            ss += (g0 * g0 + g1 * g1) + (g2 * g2 + g3 * g3);
                            base[(4 * n + 0) * 128] = f2bf(g0 * gw.x); base[(4 * n + 1) * 128] = f2bf(g1 * gw.y); base[(4 * n + 2) * 128] = f2bf(g2 * gw.z); base[(4 * n + 3) * 128] = f2bf(g3 * gw.w); }
                    }
                    ss += __shfl_xor(ss, 16); ss += __shfl_xor(ss, 32);
                    if (fq == 0) ssqv[(size_t)row * 8 + (pn - 7) * 4 + wc] = ss;
                }
        } else if (pn <= 16) {
            bf16_t* G = (pn <= 12) ? SGA + (pn - 9) * 256 : SGB + (pn - 13) * 256;
#pragma unroll
            for (int ai = 0; ai < 2; ++ai)
#pragma unroll
                for (int m = 0; m < 4; ++m) {
                    const int row = rowb + ai * 128 + m * 16; const float r = rs8[ai * 4 + m];
#pragma unroll
                    for (int bj = 0; bj < 2; ++bj) { f32x4 g[2];
#pragma unroll
                        for (int n = 0; n < 2; ++n) { const f32x4 v = acc[ai][bj][m][n] * r; g[n].x = sigmoidf_(v.x); g[n].y = sigmoidf_(v.y); g[n].z = sigmoidf_(v.z); g[n].w = sigmoidf_(v.w); }
                        *(u32x4*)(G + (size_t)row * DM + bj * 128 + wc * 32 + 8 * fq) = pack8(g[0], g[1]); }
                }
        } else {
            if (wc == 0) {
#pragma unroll
                for (int ai = 0; ai < 2; ++ai)
#pragma unroll
                    for (int m = 0; m < 4; ++m) {
                        const int row = rowb + ai * 128 + m * 16; const float r = rs8[ai * 4 + m];
#pragma unroll
                        for (int n = 0; n < 2; ++n) { const f32x4 v = acc[ai][0][m][n] * r; f32x4 g; g.x = sigmoidf_(v.x); g.y = sigmoidf_(v.y); g.z = sigmoidf_(v.z); g.w = sigmoidf_(v.w);
                            *(f32x4*)(GN + (size_t)row * 32 + 8 * fq + 4 * n) = g; }
                    }
            }
        }
    }
};

DI void transpose_item(const float* W, int K, int N, bf16_t* WT, int mode, int rowoff, LAS float* scr, int item, int lane) {
    const int nblk = (N + 63) >> 6, kb = item / nblk, nb = item % nblk, k0 = 64 * kb, n0 = 64 * nb;
    const int nn = n0 + 4 * (lane & 15);
    f32x4 v[16];
#pragma unroll
    for (int i = 0; i < 16; ++i) { const int kk = 4 * i + (lane >> 4); v[i] = (nn < N) ? __builtin_nontemporal_load((const f32x4*)(W + (size_t)(k0 + kk) * N + nn)) : (f32x4){0.f, 0.f, 0.f, 0.f}; }
#pragma unroll
    for (int i = 0; i < 16; ++i) { const int kk = 4 * i + (lane >> 4); LAS float* d = scr + kk * 65 + 4 * (lane & 15); d[0] = v[i].x; d[1] = v[i].y; d[2] = v[i].z; d[3] = v[i].w; }
    asm volatile("s_waitcnt lgkmcnt(0)" ::: "memory");
    const int c = lane & 7;
#pragma unroll
    for (int j = 0; j < 8; ++j) {
        const int n = (lane >> 3) + 8 * j; const LAS float* s = scr + (8 * c) * 65 + n;
        if (n0 + n < N) {
            const int src = n0 + n; const int row = rowoff + (mode == 1 ? map_gateup(src) : (mode == 2 ? map_win(src) : src));
            u32x4 o; o.x = pk2(s[0 * 65], s[1 * 65]); o.y = pk2(s[2 * 65], s[3 * 65]); o.z = pk2(s[4 * 65], s[5 * 65]); o.w = pk2(s[6 * 65], s[7 * 65]);
            __builtin_nontemporal_store(o, (u32x4*)(WT + (size_t)row * K + k0 + 8 * c));
        }
    }
    asm volatile("s_waitcnt lgkmcnt(0)" ::: "memory");
}

struct Params { const float* in[22]; float* out; unsigned char* ws; };

DI void convert_early(const Params& P, int l, lds_u8* L, int gw, int ngw, int wave, int lane) {
    LAS float* scr = (LAS float*)(L + wave * 16640);
    unsigned char* wb = P.ws + ((l & 1) ? W_ALT : 0);
    constexpr int I_GU = 16 * 88, I_D = 44 * 16, I_IN = 16 * 69, I_W1 = 16 * 4;
    constexpr int NITEMS = I_GU + I_D + I_IN + 4 * I_W1;
    for (int it = gw; it < NITEMS; it += ngw) {
        int r = it;
        if (r < I_GU) { transpose_item(P.in[2] + (size_t)l * DM * NGU, DM, NGU, (bf16_t*)(wb + W_GU1), 1, 0, scr, r, lane); continue; } r -= I_GU;
        if (r < I_D) { transpose_item(P.in[3] + (size_t)l * DFF * DM, DFF, DM, (bf16_t*)(wb + W_D1), 0, 0, scr, r, lane); continue; } r -= I_D;
        if (r < I_IN) { transpose_item(P.in[5] + (size_t)l * DM * NINS, DM, NINS, (bf16_t*)(wb + W_IN), 2, 0, scr, r, lane); continue; } r -= I_IN;
        if (r < I_W1) { transpose_item(P.in[8] + (size_t)l * 2048 * 256, 1024, 256, (bf16_t*)(wb + W_1K), 0, 0, scr, r, lane); continue; } r -= I_W1;
        if (r < I_W1) { transpose_item(P.in[8] + (size_t)l * 2048 * 256 + 1024 * 256, 1024, 256, (bf16_t*)(wb + W_1K), 0, 256, scr, r, lane); continue; } r -= I_W1;
        if (r < I_W1) { transpose_item(P.in[10] + (size_t)l * 2048 * 256, 1024, 256, (bf16_t*)(wb + W_1V), 0, 0, scr, r, lane); continue; } r -= I_W1;
        transpose_item(P.in[10] + (size_t)l * 2048 * 256 + 1024 * 256, 1024, 256, (bf16_t*)(wb + W_1V), 0, 256, scr, r, lane);
    }
}
DI void convert_late(const Params& P, int l, lds_u8* L, int gw, int ngw, int wave, int lane) {
    LAS float* scr = (LAS float*)(L + wave * 16640);
    unsigned char* ws = P.ws;
    constexpr int I_GU = 16 * 88, I_D = 44 * 16, I_P = 8 * 16, I_WO = 16 * 16;
    constexpr int NITEMS = I_GU + I_D + 2 * I_P + I_WO;
    for (int it = gw; it < NITEMS; it += ngw) {
        int r = it;
        if (r < I_GU) { transpose_item(P.in[19] + (size_t)l * DM * NGU, DM, NGU, (bf16_t*)(ws + W_GU2), 1, 0, scr, r, lane); continue; } r -= I_GU;
        if (r < I_D) { transpose_item(P.in[20] + (size_t)l * DFF * DM, DFF, DM, (bf16_t*)(ws + W_D2), 0, 0, scr, r, lane); continue; } r -= I_D;
        if (r < I_P) { transpose_item(P.in[15] + (size_t)l * 512 * DM, 512, DM, (bf16_t*)(ws + W_PA), 0, 0, scr, r, lane); continue; } r -= I_P;
        if (r < I_P) { transpose_item(P.in[16] + (size_t)l * 512 * DM, 512, DM, (bf16_t*)(ws + W_PB), 0, 0, scr, r, lane); continue; } r -= I_P;
        transpose_item(P.in[17] + (size_t)l * DM * DM, DM, DM, (bf16_t*)(ws + W_WO), 0, 0, scr, r, lane);
    }
}

DI void prologue_phase(const Params& P, lds_u8* L, int gw, int ngw, int tid, int lane) {
    unsigned char* ws = P.ws;
    const float* x = P.in[0]; const float* gn = P.in[1];
    bf16_t* XG = (bf16_t*)(ws + WS_XG); float* ssq = (float*)(ws + WS_SSQ);
    f32x4 g4[4];
#pragma unroll
    for (int j = 0; j < 4; ++j) g4[j] = *((const f32x4*)gn + lane + 64 * j);
    for (int row = gw; row < MT; row += ngw) {
        const f32x4* xr = (const f32x4*)(x + (size_t)row * DM) + lane; f32x4* orow = (f32x4*)(P.out + (size_t)row * DM) + lane;
        u32x2* xg = (u32x2*)(XG + (size_t)row * DM) + lane;
        float s = 0.f;
#pragma unroll
        for (int j = 0; j < 4; ++j) { const f32x4 v = __builtin_nontemporal_load(xr + 64 * j); s += (v.x * v.x + v.y * v.y) + (v.z * v.z + v.w * v.w); __builtin_nontemporal_store(v, orow + 64 * j);
            const f32x4 w = v * g4[j]; u32x2 o; o.x = pk2(w.x, w.y); o.y = pk2(w.z, w.w); xg[64 * j] = o; }
        s = wave_sum(s);
        if (lane < 16) ssq[(size_t)row * 16 + lane] = (lane == 0) ? s : 0.f;
    }
    float* cs = (float*)(ws + WS_CS); float* sn = (float*)(ws + WS_SN);
    const int gtid = blockIdx.x * 512 + tid, ngt = gridDim.x * 512;
    for (int i = gtid; i < SEQ * 32; i += ngt) {
        const int pos = i >> 5, k = i & 31;
        const float inv = __builtin_amdgcn_exp2f(-(float)k * (13.287712379549449f / 32.0f));
        const float ang = (float)pos * inv;
        const double rev = (double)ang * 0.15915494309189535; const float fr = (float)(rev - floor(rev));
        cs[i] = __builtin_amdgcn_cosf(fr); sn[i] = __builtin_amdgcn_sinf(fr);
    }
}

DI void bias_phase(const Params& P, int l, lds_u8* L, int tid, int rank) {
    if (rank >= 0 && rank < 16) {
        const int kv = rank >> 3, cgp = rank & 7;
        const float* pe = P.in[kv ? 7 : 6] + (size_t)l * 2048; const float* w1 = P.in[kv ? 10 : 8] + (size_t)l * 2048 * 256;
        const int c = cgp * 32 + (tid & 31), ksl = tid >> 5; float a = 0.f;
#pragma unroll 8
        for (int k = ksl * 128; k < ksl * 128 + 128; ++k) a += pe[k] * w1[(size_t)k * 256 + c];
        LAS float* red = (LAS float*)L;
        __syncthreads();
        red[tid] = a; __syncthreads();
        if (tid < 32) { float s = 0.f;
#pragma unroll
            for (int i = 0; i < 16; ++i) s += red[i * 32 + tid];
            ((float*)(P.ws + WS_BIAS))[(l * 2 + kv) * 256 + cgp * 32 + tid] = s; }
        __syncthreads();
    }
}

#define MFMA32(a, b, c) __builtin_amdgcn_mfma_f32_32x32x16_bf16((a), (b), (c), 0, 0, 0)
DI f32x16 zero16() { f32x16 z; for (int i = 0; i < 16; ++i) z[i] = 0.f; return z; }

DI void sgu_phase(const Params& P, int l, lds_u8* L, int tid, int wave, int lane, int rank, int nrank) {
    unsigned char* ws = P.ws;
    const float* wsg = P.in[13] + (size_t)l * 8 * 128 * 128 + (size_t)wave * 128 * 128; const float* bs = P.in[14] + (size_t)l * 8 * 128 + wave * 128;
    const bf16_t* VPT = (const bf16_t*)(ws + WS_VPT); const bf16_t* U = (const bf16_t*)(ws + WS_U); bf16_t* YB = (bf16_t*)(ws + WS_YB);
    const float* ssqv = (const float*)(ws + WS_SSQV);
    LAS float* rsv = (LAS float*)L;
    const int rho = lane & 31, hh = lane >> 5;
    if (rank >= 0) for (int c = rank; c < MT / 128; c += nrank) {
        __syncthreads();
        if (tid < 128) { const float* p = ssqv + (size_t)(c * 128 + tid) * 8; float s = 0.f;
#pragma unroll
            for (int i = 0; i < 8; ++i) s += p[i];
            rsv[tid] = rsqrtf(s * (1.0f / 512.0f) + EPS); }
        __syncthreads();
        const bf16_t* vb = VPT + ((size_t)c * 512 + wave * 64) * 128;
#pragma unroll
        for (int tt = 0; tt < 4; ++tt) {
            f32x16 a0 = zero16(), a1 = zero16();
            const int t = 32 * tt + rho;
            const float* wrow = wsg + (size_t)t * 128;
            const int nks = 2 * (tt + 1);
#pragma unroll
            for (int ks = 0; ks < nks; ++ks) {
                const int s0 = 16 * ks + 8 * hh;
                const f32x4 w0 = *(const f32x4*)(wrow + s0), w1 = *(const f32x4*)(wrow + s0 + 4);
                float wv[8] = {w0.x, w0.y, w0.z, w0.w, w1.x, w1.y, w1.z, w1.w};
#pragma unroll
                for (int j = 0; j < 8; ++j) wv[j] = (s0 + j <= t) ? wv[j] * rsv[s0 + j] : 0.f;
                u32x4 bw; bw.x = pk2(wv[0], wv[1]); bw.y = pk2(wv[2], wv[3]); bw.z = pk2(wv[4], wv[5]); bw.w = pk2(wv[6], wv[7]);
                const bf16x8 bfrag = __builtin_bit_cast(bf16x8, bw);
                const bf16x8 af0 = *(const bf16x8*)(vb + (size_t)rho * 128 + s0), af1 = *(const bf16x8*)(vb + (size_t)(32 + rho) * 128 + s0);
                a0 = MFMA32(af0, bfrag, a0); a1 = MFMA32(af1, bfrag, a1);
            }
            const float bias = bs[t]; const size_t tok = (size_t)c * 128 + t;
#pragma unroll
            for (int dt = 0; dt < 2; ++dt)
#pragma unroll
                for (int q4 = 0; q4 < 4; ++q4) {
                    const int d = wave * 64 + 32 * dt + 8 * q4 + 4 * hh;
                    const u32x2 uu = *(const u32x2*)(U + tok * 512 + d);
                    const f32x16& a = dt ? a1 : a0;
                    u32x2 o; o.x = pk2(bflo(uu.x) * (a[4 * q4 + 0] + bias), bfhi(uu.x) * (a[4 * q4 + 1] + bias)); o.y = pk2(bflo(uu.y) * (a[4 * q4 + 2] + bias), bfhi(uu.y) * (a[4 * q4 + 3] + bias));
                    *(u32x2*)(YB + tok * 512 + d) = o;
                }
        }
    }
}

DI void cmp2_phase(const Params& P, int l, lds_u8* L, int tid, int wave, int lane) {
    unsigned char* ws = P.ws;
    LAS float* hid = (LAS float*)L;
    const float* cs = (const float*)(ws + WS_CS); const float* sn = (const float*)(ws + WS_SN);
    for (int u = blockIdx.x; u < 512; u += gridDim.x) {
        const int kv = u >> 8, bg = (u >> 5) & 7, ng = u & 31;
        const float* Y = (const float*)(ws + (kv ? WS_YV : WS_YK)); const float* bias = (const float*)(ws + WS_BIAS) + (l * 2 + kv) * 256;
        const float* w2 = P.in[kv ? 11 : 9] + (size_t)l * 256 * 64;
        __syncthreads();
        { LAS f32x4* w2l4 = (LAS f32x4*)(L + 16384); const f32x4* w2g = (const f32x4*)w2;
#pragma unroll
          for (int i = 0; i < 8; ++i) w2l4[tid + 512 * i] = w2g[tid + 512 * i]; }
#pragma unroll
        for (int i = 0; i < 8; ++i) {
            const int idx = tid + 512 * i, r = idx >> 8, c = idx & 255, n = 16 * ng + r; const size_t jrow = (size_t)bg * 512 + n;
            float v = Y[jrow * 512 + c] + bias[c]; if (n < 511) v += Y[(jrow + 1) * 512 + 256 + c];
            hid[r * 256 + c] = gelu_tanh(v);
        }
        __syncthreads();
        float a0 = 0.f, a1 = 0.f; const LAS float* h0 = hid + (2 * wave) * 256; const LAS float* h1 = h0 + 256;
        const LAS float* w2l = (const LAS float*)(L + 16384) + lane;
#pragma unroll 16
        for (int k = 0; k < 256; ++k) { const float w = w2l[k * 64]; a0 += h0[k] * w; a1 += h1[k] * w; }
#pragma unroll
        for (int rr = 0; rr < 2; ++rr) {
            const int n = 16 * ng + 2 * wave + rr; float a = rr ? a1 : a0;
            if (kv == 0) {
                const float pr = __shfl_xor(a, 32); const int pos = 16 * n + 31; float o = 0.f;
                if (n < 511) { const float c = cs[pos * 32 + (lane & 31)], s = sn[pos * 32 + (lane & 31)]; o = (lane < 32) ? a * c - pr * s : a * c + pr * s; }
                ((bf16_t*)(ws + WS_KCMP))[((size_t)bg * 512 + n) * 64 + lane] = f2bf(o);
            } else {
                if (n >= 511) a = 0.f;
                ((bf16_t*)(ws + WS_VCMPT))[(((size_t)bg * 8 + (n >> 6)) * 64 + lane) * 64 + (n & 63)] = f2bf(a);
            }
        }
    }
}

constexpr int A_KB = 0, A_VB = 32768, A_IMP = 65536, IMPW = 132, A_SELM = A_IMP + 64 * IMPW * 4;
constexpr int A_QF = A_SELM + 1024;
static_assert(A_QF + 32768 <= XB_ST_OFF, "attention LDS map");
constexpr size_t WS_OF = WS_YK;

DI void attn_load(const bf16_t* kt, const bf16_t* vt, int wave, int lane, u32x4& kr, u32x4& vr) {
    kr = *(const u32x4*)(kt + lane * 64 + wave * 8); vr = *(const u32x4*)(vt + lane * 64 + wave * 8);
}
DI void attn_store(lds_u8* L, int ofs, int wave, int lane, const u32x4& kr, const u32x4& vr) {
    const int slot = (lane & ~12) | ((lane & 4) << 1) | ((lane & 8) >> 1);
    *(LAS u32x4*)(L + A_KB + ofs + wave * 1024 + slot * 16) = kr;
    *(LAS u32x4*)(L + A_VB + ofs + wave * 1024 + lane * 16) = vr;
}
DI f32x16 splat16(float v) { f32x16 z; for (int i = 0; i < 16; ++i) z[i] = v; return z; }
DI void qk_tile(lds_u8* L, int ofs, const lds_u8* qfl, int rho, int hh, float cinit, f32x16& s0, f32x16& s1) {
    const f32x16 cv = splat16(cinit);
#pragma unroll
    for (int c = 0; c < 4; ++c) {
        const lds_u8* kb = L + A_KB + ofs + (2 * c + hh) * 1024 + rho * 16;
        const bf16x8 k0 = *(const LAS bf16x8*)kb, k1 = *(const LAS bf16x8*)(kb + 512), q = *(const LAS bf16x8*)(qfl + c * 1024);
        if (c == 0) { s0 = MFMA32(k0, q, cv); s1 = MFMA32(k1, q, cv); } else { s0 = MFMA32(k0, q, s0); s1 = MFMA32(k1, q, s1); }
    }
}
DI void qk_tile_r(lds_u8* L, int ofs, const bf16x8 (&qr)[4], int rho, int hh, float cinit, f32x16& s0, f32x16& s1) {
    const f32x16 cv = splat16(cinit);
#pragma unroll
    for (int c = 0; c < 4; ++c) {
        const lds_u8* kb = L + A_KB + ofs + (2 * c + hh) * 1024 + rho * 16;
        const bf16x8 k0 = *(const LAS bf16x8*)kb, k1 = *(const LAS bf16x8*)(kb + 512);
        if (c == 0) { s0 = MFMA32(k0, qr[0], cv); s1 = MFMA32(k1, qr[0], cv); } else { s0 = MFMA32(k0, qr[c], s0); s1 = MFMA32(k1, qr[c], s1); }
    }
}
DI void mask_range(f32x16& s0, f32x16& s1, int hh, int lo, int hi) {
#pragma unroll
    for (int i = 0; i < 16; ++i) { const int k = 16 * (i >> 3) + 8 * hh + (i & 7);
        if (k < lo || k > hi) s0[i] = -INFINITY; if (k + 32 < lo || k + 32 > hi) s1[i] = -INFINITY; }
}
DI float xhalf_max(float a) {
    const unsigned u = __float_as_uint(a);
    auto rr = __builtin_amdgcn_permlane32_swap(u, u, false, false);
    return fmaxf(__uint_as_float(rr[0]), __uint_as_float(rr[1]));
}
DI float tile_max_lane(const f32x16& s0, const f32x16& s1) {
    float a = fmaxf(fmaxf(s0[0], s1[0]), s0[1]), b = fmaxf(fmaxf(s1[1], s0[2]), s1[2]);
#pragma unroll
    for (int i = 3; i < 15; i += 2) { a = fmaxf(fmaxf(a, s0[i]), s1[i]); b = fmaxf(fmaxf(b, s0[i + 1]), s1[i + 1]); }
    a = fmaxf(fmaxf(a, s0[15]), s1[15]); return fmaxf(a, b);
}
DI void pv_tile(lds_u8* L, int ofs, const f32x16& p0, const f32x16& p1, int rho, int hh, f32x16& o0, f32x16& o1) {
#pragma unroll
    for (int sub = 0; sub < 2; ++sub)
#pragma unroll
        for (int s = 0; s < 2; ++s) {
            const f32x16& p = sub ? p1 : p0;
            u32x4 w; w.x = pk2(p[8 * s + 0], p[8 * s + 1]); w.y = pk2(p[8 * s + 2], p[8 * s + 3]); w.z = pk2(p[8 * s + 4], p[8 * s + 5]); w.w = pk2(p[8 * s + 6], p[8 * s + 7]);
            const bf16x8 pf = __builtin_bit_cast(bf16x8, w);
            const lds_u8* vb = L + A_VB + ofs + (2 * (2 * sub + s) + hh) * 1024 + rho * 16;
            const bf16x8 v0 = *(const LAS bf16x8*)vb, v1 = *(const LAS bf16x8*)(vb + 512);
            o0 = MFMA32(v0, pf, o0); o1 = MFMA32(v1, pf, o1);
        }
}

template <int MODE>
DI void tile_range(int tt, int t_hi, int qb, int ql, int nmax, u64 sel_lo, u64 sel_hi, int& lo, int& hi) {
    lo = 0; hi = 63;
    const int tq = (tt <= t_hi) ? tt : 0;
    if (MODE <= 1) hi = nmax - 64 * tq;
    if (MODE == 2) { const u64 wsel = (tq < 64) ? (sel_lo >> tq) : (sel_hi >> (tq - 64)); hi = (wsel & 1ull) ? ((tq == qb) ? ql : 63) : -1; }
    if (MODE == 3) { if (tq == qb) hi = ql; if (tq == qb - 8) lo = ql + 1; }
    if (hi > 63) hi = 63;
    if (tt > t_hi) hi = -1;
}
DI float quad_xor1(float v) { return __int_as_float(__builtin_amdgcn_update_dpp(0, __float_as_int(v), 0xB1, 0xF, 0xF, true)); }
DI float quad_xor2(float v) { return __int_as_float(__builtin_amdgcn_update_dpp(0, __float_as_int(v), 0x4E, 0xF, 0xF, true)); }
DI void imp_accum(const f32x16& s0, const f32x16& s1, int tt, int rho, int hh, LAS float* improw, float& carry) {
    float a[4], b[4], x[4];
#pragma unroll
    for (int r = 0; r < 4; ++r) {
        const f32x16& p = (r >> 1) ? s1 : s0; const int o = 8 * (r & 1);
        a[r] = p[o + 0] + p[o + 1] + p[o + 2] + 0.5f * p[o + 3];
        b[r] = 0.5f * p[o + 3] + p[o + 4] + p[o + 5] + p[o + 6] + 0.5f * p[o + 7];
        x[r] = __shfl_xor(0.5f * p[o + 7], 32);
    }
    float E[4];
    E[0] = a[0] + (hh ? x[0] : carry);
#pragma unroll
    for (int r = 1; r < 4; ++r) E[r] = a[r] + (hh ? x[r] : x[r - 1]);
    carry = x[3];
#pragma unroll
    for (int r = 0; r < 4; ++r) { E[r] += quad_xor1(E[r]); E[r] += quad_xor2(E[r]); b[r] += quad_xor1(b[r]); b[r] += quad_xor2(b[r]); }
    if ((rho & 3) == 0) { LAS float* d = improw + 16 * tt + 2 * hh;
#pragma unroll
        for (int r = 0; r < 4; ++r) { d[4 * r] = E[r]; d[4 * r + 1] = b[r]; } }
}
template <int MODE>
DI void attn_run(lds_u8* L, const bf16_t* Kb, const bf16_t* Vb, int t_lo, int t_hi, const lds_u8* qf, int wave, int lane, int qb, int ql, int nmax,
                 u64 sel_lo, u64 sel_hi, float& m, float& l, int& started, f32x16& o0, f32x16& o1, float inv_l, LAS float* improw) {
    const int rho = lane & 31, hh = lane >> 5;
    const int npair = (t_hi - t_lo + 2) >> 1;
    float icarry = 0.f;
    u32x4 kr0, vr0, kr1, vr1;
    { const int tb0 = (t_lo + 1 <= t_hi) ? t_lo + 1 : t_lo;
      attn_load(Kb + (size_t)t_lo * 4096, Vb + (size_t)t_lo * 4096, wave, lane, kr0, vr0);
      attn_load(Kb + (size_t)tb0 * 4096, Vb + (size_t)tb0 * 4096, wave, lane, kr1, vr1); }
    attn_store(L, 0, wave, lane, kr0, vr0); attn_store(L, 8192, wave, lane, kr1, vr1);
    __syncthreads();
    int st = 0;
    for (int pi = 0; pi < npair; ++pi) {
        const int ta = t_lo + 2 * pi, tb = ta + 1;
        const bool more = pi + 1 < npair;
        if (more) { const int na = ta + 2, nb = (ta + 3 <= t_hi) ? ta + 3 : t_lo;
            attn_load(Kb + (size_t)na * 4096, Vb + (size_t)na * 4096, wave, lane, kr0, vr0);
            attn_load(Kb + (size_t)nb * 4096, Vb + (size_t)nb * 4096, wave, lane, kr1, vr1); }
        int loA, hiA, loB, hiB;
        tile_range<MODE>(ta, t_hi, qb, ql, nmax, sel_lo, sel_hi, loA, hiA);
        tile_range<MODE>(tb, t_hi, qb, ql, nmax, sel_lo, sel_hi, loB, hiB);
        const bool actA = (hiA >= loA) && (hiA >= 0), actB = (hiB >= loB) && (hiB >= 0);
        if (__ballot(actA || actB) == 0ull) icarry = 0.f;
        if (__ballot(actA || actB) != 0ull) {
            const int so = st * 16384;
            f32x16 a0, a1, b0, b1;
            qk_tile(L, so, qf, rho, hh, actA ? -m : -INFINITY, a0, a1);
            asm volatile("" ::: "memory");
            qk_tile(L, so + 8192, qf, rho, hh, actB ? -m : -INFINITY, b0, b1);
            asm volatile("" ::: "memory");
            if (__ballot(actA && (loA > 0 || hiA < 63)) != 0ull) mask_range(a0, a1, hh, loA, hiA);
            if (__ballot(actB && (loB > 0 || hiB < 63)) != 0ull) mask_range(b0, b1, hh, loB, hiB);
            if (MODE != 1) {
                float rm = fmaxf(tile_max_lane(a0, a1), tile_max_lane(b0, b1)); rm = xhalf_max(rm);
                float delta = 0.f; bool first = false;
                if (rm > -INFINITY) { if (!started) { delta = rm; first = true; started = 1; } else if (rm > 8.f) delta = rm; }
                if (__ballot(delta != 0.f) != 0ull) {
                    m += delta; const float f = first ? 1.0f : __builtin_amdgcn_exp2f(-delta); l *= f;
#pragma unroll
                    for (int i = 0; i < 16; ++i) { a0[i] -= delta; a1[i] -= delta; b0[i] -= delta; b1[i] -= delta; if (MODE >= 2) { o0[i] *= f; o1[i] *= f; } }
                }
                float sum = 0.f, sum2 = 0.f;
#pragma unroll
                for (int i = 0; i < 16; ++i) { a0[i] = __builtin_amdgcn_exp2f(a0[i]); a1[i] = __builtin_amdgcn_exp2f(a1[i]); sum += a0[i] + a1[i]; }
#pragma unroll
                for (int i = 0; i < 16; ++i) { b0[i] = __builtin_amdgcn_exp2f(b0[i]); b1[i] = __builtin_amdgcn_exp2f(b1[i]); sum2 += b0[i] + b1[i]; }
                l += sum + sum2;
                if (MODE >= 2) { pv_tile(L, so, a0, a1, rho, hh, o0, o1); asm volatile("" ::: "memory"); pv_tile(L, so + 8192, b0, b1, rho, hh, o0, o1); }
            } else {
#pragma unroll
                for (int i = 0; i < 16; ++i) { a0[i] = __builtin_amdgcn_exp2f(a0[i]) * inv_l; a1[i] = __builtin_amdgcn_exp2f(a1[i]) * inv_l;
                                               b0[i] = __builtin_amdgcn_exp2f(b0[i]) * inv_l; b1[i] = __builtin_amdgcn_exp2f(b1[i]) * inv_l; }
                pv_tile(L, so, a0, a1, rho, hh, o0, o1); asm volatile("" ::: "memory"); pv_tile(L, so + 8192, b0, b1, rho, hh, o0, o1);
                imp_accum(a0, a1, ta, rho, hh, improw, icarry);
                if (tb <= t_hi) imp_accum(b0, b1, tb, rho, hh, improw, icarry);
            }
        }
        if (more) { attn_store(L, (st ^ 1) * 16384, wave, lane, kr0, vr0); attn_store(L, (st ^ 1) * 16384 + 8192, wave, lane, kr1, vr1); }
        __syncthreads();
        st ^= 1;
    }
}

DI void pv_packed(lds_u8* L, int ofs, const u32x4 (&pw)[4], int rho, int hh, f32x16& o0, f32x16& o1) {
#pragma unroll
    for (int c16 = 0; c16 < 4; ++c16) {
        const bf16x8 pf = __builtin_bit_cast(bf16x8, pw[c16]);
        const lds_u8* vb = L + A_VB + ofs + (2 * c16 + hh) * 1024 + rho * 16;
        const bf16x8 v0 = *(const LAS bf16x8*)vb, v1 = *(const LAS bf16x8*)(vb + 512);
        o0 = MFMA32(v0, pf, o0); o1 = MFMA32(v1, pf, o1);
    }
}
template <int MODE>
DI void attn_stag(lds_u8* L, const bf16_t* Kb, const bf16_t* Vb, int t_lo, int t_hi, const lds_u8* qf, int wave, int lane, int qb, int ql,
                  u64 sel_lo, u64 sel_hi, float& m, float& l, int& started, f32x16& o0, f32x16& o1) {
    const int rho = lane & 31, hh = lane >> 5;
    const bool late = wave >= 4;
    bf16x8 qr[4];
#pragma unroll
    for (int c = 0; c < 4; ++c) qr[c] = *(const LAS bf16x8*)(qf + c * 1024);
    u32x4 kr, vr;
    attn_load(Kb + (size_t)t_lo * 4096, Vb + (size_t)t_lo * 4096, wave, lane, kr, vr);
    { const int slot = (lane & ~12) | ((lane & 4) << 1) | ((lane & 8) >> 1);
      *(LAS u32x4*)(L + A_KB + wave * 1024 + slot * 16) = kr; *(LAS u32x4*)(L + A_VB + wave * 1024 + lane * 16) = vr; }
    __syncthreads();
    u32x4 pw[4]; bool havep = false; int vprev = 0, ks = 0, vs = 0;
    for (int tt = t_lo; tt <= t_hi; ++tt) {
        const bool more = tt < t_hi;
        if (more) attn_load(Kb + (size_t)(tt + 1) * 4096, Vb + (size_t)(tt + 1) * 4096, wave, lane, kr, vr);
        int lo, hi; tile_range<MODE>(tt, t_hi, qb, ql, 0, sel_lo, sel_hi, lo, hi);
        const bool act = (hi >= lo) && (hi >= 0);
        if (late && havep) { pv_packed(L, vprev * 8192, pw, rho, hh, o0, o1); havep = false; }
        if (__ballot(act) != 0ull) {
            f32x16 s0, s1; qk_tile_r(L, ks * 8192, qr, rho, hh, act ? -m : -INFINITY, s0, s1);
            asm volatile("" ::: "memory");
            if (__ballot(act && (lo > 0 || hi < 63)) != 0ull) mask_range(s0, s1, hh, lo, hi);
            float rm = tile_max_lane(s0, s1); rm = xhalf_max(rm);
            float delta = 0.f; bool first = false;
            if (rm > -INFINITY) { if (!started) { delta = rm; first = true; started = 1; } else if (rm > 8.f) delta = rm; }
            if (__ballot(delta != 0.f) != 0ull) {
                m += delta; const float f = first ? 1.0f : __builtin_amdgcn_exp2f(-delta); l *= f;
#pragma unroll
                for (int i = 0; i < 16; ++i) { s0[i] -= delta; s1[i] -= delta; o0[i] *= f; o1[i] *= f; }
            }
            float sum = 0.f;
#pragma unroll
            for (int i = 0; i < 16; ++i) { s0[i] = __builtin_amdgcn_exp2f(s0[i]); s1[i] = __builtin_amdgcn_exp2f(s1[i]); sum += s0[i]; sum += s1[i]; }
            l += sum;
#pragma unroll
            for (int c16 = 0; c16 < 4; ++c16) { const f32x16& p = (c16 >> 1) ? s1 : s0; const int b8 = 8 * (c16 & 1);
                pw[c16].x = pk2(p[b8 + 0], p[b8 + 1]); pw[c16].y = pk2(p[b8 + 2], p[b8 + 3]); pw[c16].z = pk2(p[b8 + 4], p[b8 + 5]); pw[c16].w = pk2(p[b8 + 6], p[b8 + 7]); }
            if (!late) pv_packed(L, vs * 8192, pw, rho, hh, o0, o1); else { havep = true; vprev = vs; }
        }
        const int ks1 = ks ^ 1, vs1 = (vs == 2) ? 0 : vs + 1;
        if (more) { const int slot = (lane & ~12) | ((lane & 4) << 1) | ((lane & 8) >> 1);
            *(LAS u32x4*)(L + A_KB + ks1 * 8192 + wave * 1024 + slot * 16) = kr; *(LAS u32x4*)(L + A_VB + vs1 * 8192 + wave * 1024 + lane * 16) = vr; }
        __syncthreads();
        ks = ks1; vs = vs1;
    }
    if (late && havep) pv_packed(L, vprev * 8192, pw, rho, hh, o0, o1);
    __syncthreads();
}

DI void attn_phase(const Params& P, lds_u8* L, int tid, int wave, int lane) {
    unsigned char* ws = P.ws;
    const bf16_t* Q = (const bf16_t*)(ws + WS_Q); const float* GN = (const float*)(ws + WS_GN); bf16_t* YA = (bf16_t*)(ws + WS_YA);
    const int rho = lane & 31, hh = lane >> 5, hd = rho & 3;
    LAS float* improw = (LAS float*)(L + A_IMP) + (wave * 8 + (rho >> 2)) * IMPW;
    LAS float* impw = (LAS float*)(L + A_IMP) + wave * 8 * IMPW;
    LAS u64* selm = (LAS u64*)(L + A_SELM);
    f32x4* ofl = (f32x4*)(ws + WS_OF) + ((size_t)blockIdx.x * 512 + tid) * 8;
    for (int u = blockIdx.x; u < 1024; u += gridDim.x) {
        const int iq = u >> 8, v = u & 255, bg = v & 7, sI = v >> 3;
        const int qb = (iq == 0) ? sI : (iq == 1) ? 63 - sI : (iq == 2) ? 64 + sI : 127 - sI;
        const int b = bg >> 1, g = bg & 1;
        const int ql = 8 * wave + (rho >> 2), t = 64 * qb + ql; const size_t tok = (size_t)b * SEQ + t;
        lds_u8* qf = L + A_QF + wave * 4096 + lane * 16;
#pragma unroll
        for (int c = 0; c < 4; ++c) *(LAS bf16x8*)(qf + c * 1024) = *(const bf16x8*)(Q + tok * 512 + g * 256 + hd * 64 + 16 * c + 8 * hh);
        for (int i = lane; i < 8 * IMPW; i += 64) impw[i] = 0.f;
        const bf16_t* Kc = (const bf16_t*)(ws + WS_KCMP) + (size_t)bg * 512 * 64; const bf16_t* Vc = (const bf16_t*)(ws + WS_VCMPT) + (size_t)bg * 512 * 64;
        const bf16_t* Ks = (const bf16_t*)(ws + WS_KSEL) + (size_t)bg * SEQ * 64; const bf16_t* Vs = (const bf16_t*)(ws + WS_VSELT) + (size_t)bg * SEQ * 64;
        const bf16_t* Kw = (const bf16_t*)(ws + WS_KWIN) + (size_t)bg * SEQ * 64; const bf16_t* Vw = (const bf16_t*)(ws + WS_VWINT) + (size_t)bg * SEQ * 64;
        const int nmax = (t - 31) >> 4;
        const int tc_hi = (4 * qb + 2) >> 6;
        f32x16 of0, of1, o0, o1; float m, l; int started;
#ifdef DUP_CMP
        for (int rep_ = 0; rep_ < 2; ++rep_) {
        if (rep_) { asm volatile("" :: "v"(o0), "v"(o1)); for (int i = lane; i < 8 * IMPW; i += 64) impw[i] = 0.f; }
#endif
        m = 0.f; l = 0.f; started = 0; o0 = zero16(); o1 = zero16();
        attn_run<0>(L, Kc, Vc, 0, tc_hi, qf, wave, lane, qb, ql, nmax, 0ull, 0ull, m, l, started, o0, o1, 0.f, improw);
        l += __shfl_xor(l, 32);
        const float inv_l = (l > 0.f) ? 1.0f / l : 0.f;
        attn_run<1>(L, Kc, Vc, 0, tc_hi, qf, wave, lane, qb, ql, nmax, 0ull, 0ull, m, l, started, o0, o1, inv_l, improw);
#pragma unroll
        for (int i = 0; i < 4; ++i) { const float gc = GN[tok * 32 + (g * 4 + hd) * 3 + 0];
            ofl[i] = (f32x4){gc * o0[4 * i], gc * o0[4 * i + 1], gc * o0[4 * i + 2], gc * o0[4 * i + 3]}; ofl[4 + i] = (f32x4){gc * o1[4 * i], gc * o1[4 * i + 1], gc * o1[4 * i + 2], gc * o1[4 * i + 3]}; }
        if (qb > 15) {
            const bool cand0 = lane < qb, cand1 = lane + 64 < qb; const u64 ltm = (1ull << lane) - 1ull;
            for (int qi = 0; qi < 8; ++qi) {
                const LAS float* row = impw + qi * IMPW;
                const unsigned k0 = cand0 ? __float_as_uint(row[lane]) : 0u, k1 = cand1 ? __float_as_uint(row[lane + 64]) : 0u;
                unsigned prefix = 0u;
                for (int bit = 30; bit >= 0; --bit) {
                    const unsigned trial = prefix | (1u << bit);
                    const int cnt = __popcll(__ballot(cand0 && k0 >= trial)) + __popcll(__ballot(cand1 && k1 >= trial));
                    if (cnt >= 15) prefix = trial;
                }
                const u64 gt0 = __ballot(cand0 && k0 > prefix), gt1 = __ballot(cand1 && k1 > prefix);
                const u64 eq0 = __ballot(cand0 && k0 == prefix), eq1 = __ballot(cand1 && k1 == prefix);
                const int need = 15 - (__popcll(gt0) + __popcll(gt1));
                const int r0 = __popcll(eq0 & ltm), r1 = __popcll(eq0) + __popcll(eq1 & ltm);
                const bool s0 = (lane == qb) || (cand0 && (k0 > prefix || (k0 == prefix && r0 < need)));
                const bool s1 = (lane + 64 == qb) || (cand1 && (k1 > prefix || (k1 == prefix && r1 < need)));
                const u64 m0 = __ballot(s0), m1 = __ballot(s1);
                if (lane == 0) { selm[(wave * 8 + qi) * 2] = m0; selm[(wave * 8 + qi) * 2 + 1] = m1; }
            }
        } else {
            if (lane < 8) { selm[(wave * 8 + lane) * 2] = (1ull << (qb + 1)) - 1ull; selm[(wave * 8 + lane) * 2 + 1] = 0ull; }
        }
        const u64 sel_lo = selm[(wave * 8 + (rho >> 2)) * 2], sel_hi = selm[(wave * 8 + (rho >> 2)) * 2 + 1];
        m = 0.f; l = 0.f; started = 0; o0 = zero16(); o1 = zero16();
        attn_stag<2>(L, Ks, Vs, 0, qb, qf, wave, lane, qb, ql, sel_lo, sel_hi, m, l, started, o0, o1);
#ifdef DUP_SEL
        asm volatile("" :: "v"(o0), "v"(o1), "v"(l), "v"(m));
        m = 0.f; l = 0.f; started = 0; o0 = zero16(); o1 = zero16();
        attn_stag<2>(L, Ks, Vs, 0, qb, qf, wave, lane, qb, ql, sel_lo, sel_hi, m, l, started, o0, o1);
#endif
        l += __shfl_xor(l, 32);
        { const float f = GN[tok * 32 + (g * 4 + hd) * 3 + 1] / l;
#pragma unroll
          for (int i = 0; i < 4; ++i) { ofl[i] = ofl[i] + (f32x4){f * o0[4 * i], f * o0[4 * i + 1], f * o0[4 * i + 2], f * o0[4 * i + 3]}; ofl[4 + i] = ofl[4 + i] + (f32x4){f * o1[4 * i], f * o1[4 * i + 1], f * o1[4 * i + 2], f * o1[4 * i + 3]}; } }
        m = 0.f; l = 0.f; started = 0; o0 = zero16(); o1 = zero16();
        attn_stag<3>(L, Kw, Vw, (qb >= 8) ? qb - 8 : 0, qb, qf, wave, lane, qb, ql, 0ull, 0ull, m, l, started, o0, o1);
        l += __shfl_xor(l, 32);
        { const float f = GN[tok * 32 + (g * 4 + hd) * 3 + 2] / l;
#pragma unroll
          for (int i = 0; i < 4; ++i) { const f32x4 pa = ofl[i], pb = ofl[4 + i];
            of0[4 * i] = pa.x + f * o0[4 * i]; of0[4 * i + 1] = pa.y + f * o0[4 * i + 1]; of0[4 * i + 2] = pa.z + f * o0[4 * i + 2]; of0[4 * i + 3] = pa.w + f * o0[4 * i + 3];
            of1[4 * i] = pb.x + f * o1[4 * i]; of1[4 * i + 1] = pb.y + f * o1[4 * i + 1]; of1[4 * i + 2] = pb.z + f * o1[4 * i + 2]; of1[4 * i + 3] = pb.w + f * o1[4 * i + 3]; } }
        bf16_t* yo = YA + tok * 512 + (g * 4 + hd) * 64 + 4 * hh;
#pragma unroll
        for (int q4 = 0; q4 < 4; ++q4) {
            u32x2 a; a.x = pk2(of0[4 * q4 + 0], of0[4 * q4 + 1]); a.y = pk2(of0[4 * q4 + 2], of0[4 * q4 + 3]); *(u32x2*)(yo + 8 * q4) = a;
            u32x2 c; c.x = pk2(of1[4 * q4 + 0], of1[4 * q4 + 1]); c.y = pk2(of1[4 * q4 + 2], of1[4 * q4 + 3]); *(u32x2*)(yo + 32 + 8 * q4) = c;
        }
    }
}

DI void final_phase(const Params& P, int gw, int ngw, int lane) {
    const float* ssq = (const float*)(P.ws + WS_SSQ); const float* gn = P.in[21];
    f32x4 g4[4];
#pragma unroll
    for (int j = 0; j < 4; ++j) g4[j] = *((const f32x4*)gn + lane + 64 * j);
    for (int row = gw; row < MT; row += ngw) {
        float s = (lane < 16) ? ssq[(size_t)row * 16 + lane] : 0.f; s = wave_sum(s);
        const float r = rsqrtf(s * (1.0f / 1024.0f) + EPS);
        f32x4* xr = (f32x4*)(P.out + (size_t)row * DM) + lane;
#pragma unroll
        for (int j = 0; j < 4; ++j) { const f32x4 v = __builtin_nontemporal_load(xr + 64 * j); __builtin_nontemporal_store(v * g4[j] * r, xr + 64 * j); }
    }
}

#define GEMM(EPI, A_, B_, M_, N_, K_, CID, E_) do { pg8::Gemm g_{(const bf16_t*)(A_), (const bf16_t*)(B_), (M_), (N_), (K_)}; pg8::StaticOrder S_; S_.init((M_), (N_), G, (CID)); \
    pg8::gemm_phase<EPI, pg8::StaticOrder, true, true>(L, g_, S_, (E_)); } while (0)

DI const Params& getP() { auto p = __builtin_amdgcn_kernarg_segment_ptr(); asm volatile("" : "+s"(p)); return *(const Params*)p; }

__global__ void __launch_bounds__(512, 2) mega_fwd(Params Pk) {
    extern __shared__ __attribute__((aligned(16))) unsigned char lds_raw[];
    lds_u8* L = (lds_u8*)lds_raw;
#ifndef PM
#define PM 0xFFFF
#endif
#define PHASE_BEGIN const Params& P = getP(); unsigned char* ws = P.ws; (void)ws; int G = gridDim.x, bid = blockIdx.x; asm volatile("" : "+s"(G), "+s"(bid)); const int ngw = G * 8; (void)ngw; int l = lyr; asm volatile("" : "+s"(l)); (void)l; int tid = threadIdx.x; asm volatile("" : "+v"(tid)); \
    const int lane = tid & 63, wave = __builtin_amdgcn_readfirstlane(tid >> 6), gw = bid * 8 + wave; (void)lane; (void)gw;
#define XP_ float* X = P.out; bf16_t* XG = (bf16_t*)(ws + WS_XG); bf16_t* H = (bf16_t*)(ws + WS_H); float* ssq = (float*)(ws + WS_SSQ); \
    bf16_t* SGA = (bf16_t*)(ws + WS_SGA); bf16_t* SGB = (bf16_t*)(ws + WS_SGB); (void)X; (void)XG; (void)H; (void)ssq; (void)SGA; (void)SGB;

    { LAS unsigned* st0 = (LAS unsigned*)(L + XB_ST_OFF); if (threadIdx.x < 2) st0[threadIdx.x] = 0u; __syncthreads();
      (void)xcd_barrier_post((unsigned*)(getP().ws + WS_CTL), (volatile LAS unsigned*)st0); }
#define XSYNC_ONE() do { XcdBarrier xb_; xb_.bar = (unsigned*)(getP().ws + WS_CTL); xb_.x = xb_xcc_id(); xb_.st = (volatile LAS unsigned*)(L + XB_ST_OFF); xcd_barrier(xb_); } while (0)
#ifdef DUP_SYNC
#define GRID_SYNC() do { XSYNC_ONE(); XSYNC_ONE(); } while (0)
#else
#define GRID_SYNC() XSYNC_ONE()
#endif
    int lyr = 0;
    if (PM & 1) { PHASE_BEGIN prologue_phase(P, L, gw, ngw, tid, lane); }
#ifdef DUP_PRO
    { PHASE_BEGIN prologue_phase(P, L, gw, ngw, tid, lane); }
    { PHASE_BEGIN prologue_phase(P, L, gw, ngw, tid, lane); }
#endif
    __syncthreads();
    if (PM & 2) { PHASE_BEGIN convert_early(P, 0, L, gw, ngw, wave, lane); }
    cg::this_grid().sync();
#pragma nounroll
    for (lyr = 0; lyr < DEPTH; ++lyr) {
#define WB_ (ws + ((l & 1) ? W_ALT : 0))
        if (PM & 4) { PHASE_BEGIN XP_ EpiGateUp E{H, ssq}; GEMM(EpiGateUp, XG, WB_ + W_GU1, MT, NGU, DM, bid, E); }
#ifdef DUP_GU
        GRID_SYNC();
        { PHASE_BEGIN XP_ EpiGateUp E{H, ssq}; GEMM(EpiGateUp, XG, WB_ + W_GU1, MT, NGU, DM, bid, E); }
#endif
        GRID_SYNC();
        if (PM & 8) { PHASE_BEGIN XP_ EpiResid E{X, XG, P.in[4] + l * DM, ssq, 0.5f}; GEMM(EpiResid, H, WB_ + W_D1, MT, DM, DFF, bid, E); }
        GRID_SYNC();
        if (PM & 16) { PHASE_BEGIN XP_ EpiWin E{ws, P.in[12] + l * 512};
          GEMM(EpiWin, XG, WB_ + W_IN, MT, NINP, DM, bid, E); }
#ifdef DUP_WIN
        GRID_SYNC();
        { PHASE_BEGIN XP_ EpiWin E{ws, P.in[12] + l * 512};
          GEMM(EpiWin, XG, WB_ + W_IN, MT, NINP, DM, bid, E); }
#endif
        GRID_SYNC();
        if (PM & 32) { PHASE_BEGIN EpiF32 E{(float*)(ws + WS_YK), 512}; GEMM(EpiF32, ws + WS_KC, WB_ + W_1K, 4096, 512, 1024, bid, E); }
        if (PM & 32) { PHASE_BEGIN EpiF32 E{(float*)(ws + WS_YV), 512}; GEMM(EpiF32, ws + WS_VC, WB_ + W_1V, 4096, 512, 1024, (bid + G / 2) % G, E); }
#define P4RANK const int rank = bid, nrank = G; (void)nrank;
        if (PM & 64) { PHASE_BEGIN bias_phase(P, l, L, tid, (G >= 64) ? bid - 32 : bid); }
        if (PM & 64) { PHASE_BEGIN P4RANK sgu_phase(P, l, L, tid, wave, lane, rank, nrank); }
        __syncthreads();
        if (PM & 2) { PHASE_BEGIN P4RANK if (rank >= 0) convert_late(P, l, L, rank * 8 + wave, nrank * 8, wave, lane); }
#ifdef DUP_CONV
        { PHASE_BEGIN convert_late(P, l, L, gw, ngw, wave, lane); }
#endif
        GRID_SYNC();
        if (PM & 128) { PHASE_BEGIN cmp2_phase(P, l, L, tid, wave, lane); }
        __syncthreads();
        if (PM & 2) { PHASE_BEGIN if (l + 1 < DEPTH) convert_early(P, l + 1, L, gw, ngw, wave, lane); }
#ifdef DUP_CONV
        { PHASE_BEGIN if (l + 1 < DEPTH) convert_early(P, l + 1, L, gw, ngw, wave, lane); }
#endif
        GRID_SYNC();
        if (PM & 256) { PHASE_BEGIN attn_phase(P, L, tid, wave, lane); }
#ifdef DUP_ATT
        GRID_SYNC();
        { PHASE_BEGIN attn_phase(P, L, tid, wave, lane); }
#endif
        GRID_SYNC();
        if (PM & 512) { PHASE_BEGIN XP_ EpiProj E{SGA, SGB, 0}; GEMM(EpiProj, ws + WS_YA, ws + W_PA, MT, DM, 512, bid, E); }
        if (PM & 512) { PHASE_BEGIN XP_ EpiProj E{SGA, SGB, 1}; GEMM(EpiProj, ws + WS_YB, ws + W_PB, MT, DM, 512, bid, E); }
        GRID_SYNC();
        if (PM & 1024) { PHASE_BEGIN XP_ EpiResid E{X, XG, P.in[18] + l * DM, ssq, 1.0f}; GEMM(EpiResid, SGB, ws + W_WO, MT, DM, DM, bid, E); }
        GRID_SYNC();
        if (PM & 2048) { PHASE_BEGIN XP_ EpiGateUp E{H, ssq}; GEMM(EpiGateUp, XG, ws + W_GU2, MT, NGU, DM, bid, E); }
        GRID_SYNC();
        if (PM & 4096) { PHASE_BEGIN XP_ EpiResid E{X, XG, P.in[1] + ((l + 1 < DEPTH) ? (l + 1) : l) * DM, ssq, 0.5f}; GEMM(EpiResid, H, ws + W_D2, MT, DM, DFF, bid, E); }
        GRID_SYNC();
    }
    if (PM & 8192) { PHASE_BEGIN final_phase(P, gw, ngw, lane); }
}

extern "C" void kernel_launch(void* const* d_in, const int* in_sizes, int n_in, void* d_out, int out_size, void* d_ws, size_t ws_size, hipStream_t stream) {
    static int grid = 0;
    if (grid == 0) {
        if (n_in != 22 || out_size != MT * DM || ws_size < WS_END) { fprintf(stderr, "kernel_launch: unexpected shapes (n_in %d, out %d, ws %zu)\n", n_in, out_size, ws_size); grid = -1; return; }
        int dev = 0, cus = 0, per_cu = 0;
        hipGetDevice(&dev); hipDeviceGetAttribute(&cus, hipDeviceAttributeMultiprocessorCount, dev);
        hipFuncSetAttribute((const void*)mega_fwd, hipFuncAttributeMaxDynamicSharedMemorySize, LDS_BYTES);
        hipOccupancyMaxActiveBlocksPerMultiprocessor(&per_cu, (const void*)mega_fwd, 512, LDS_BYTES);
        (void)hipGetLastError();
        if (per_cu < 1) per_cu = 1;
        grid = cus * per_cu;
        if (grid > 256) grid = 256;
    }
    if (grid < 0) return;
    if (hipMemsetAsync((char*)d_ws + WS_CTL, 0, 16384, stream) != hipSuccess) { fprintf(stderr, "kernel_launch: memset of barrier words failed\n"); return; }
    Params p{};
    for (int i = 0; i < 22; ++i) p.in[i] = (const float*)d_in[i];
    p.out = (float*)d_out; p.ws = (unsigned char*)d_ws;
    void* args[] = {&p};
    hipError_t e = hipLaunchCooperativeKernel((const void*)mega_fwd, dim3(grid), dim3(512), args, LDS_BYTES, stream);
    if (e != hipSuccess) fprintf(stderr, "cooperative launch failed: %s (grid %d)\n", hipGetErrorString(e), grid);
}
```
